# Optimizing an MI355X kernel written in HIP

```python
import math
import jax, jax.numpy as jnp
from jax import lax
import numpy as np

D_MODEL = 1024
BATCH = 2
SEQ = 8192
DEPTH = 1

MEM_TOKENS = 256
N_MEM_HEADS = 4
DH_MEM = 128
MEM_WIDTH = N_MEM_HEADS * DH_MEM
N_DIFF_HEADS = 8
DH_DIFF = 64
DIFF_Q_WIDTH = N_DIFF_HEADS * 2 * DH_DIFF
DIFF_V_WIDTH = N_DIFF_HEADS * 2 * DH_DIFF
Q_BLOCK = 128
POOL_WINDOWS = (2, 4, 8, 16)
POOL_GROUPS = len(POOL_WINDOWS)
POOL_GROUP_WIDTH = 128
POOL_WIDTH = POOL_GROUPS * POOL_GROUP_WIDTH
N_BRANCHES = 3
IN_COLS = 2 * DIFF_Q_WIDTH + DIFF_V_WIDTH + POOL_WIDTH + MEM_WIDTH + N_BRANCHES * D_MODEL
D_FF = 2816
CONV_WIDTH = 3
NORM_EPS = 1e-6

kernel_name = "hybrid_diffattn_pool_memxattn_convffn"


def rms_norm(x, g):
    xf = x.astype(jnp.float32)
    y = xf * lax.rsqrt(jnp.mean(xf * xf, axis=-1, keepdims=True) + NORM_EPS)
    return (y * g.astype(jnp.float32)).astype(x.dtype)


def alibi_slopes(n_heads):
    return jnp.exp2(-8.0 * jnp.arange(1, n_heads + 1, dtype=jnp.float32) / n_heads)


def lambda_init_for(layer_idx):
    return 0.8 - 0.6 * math.exp(-0.3 * layer_idx)


def diff_attention(q, k, v, lam):
    B, S = q.shape[0], q.shape[1]
    n_blocks = S // Q_BLOCK
    scale = DH_DIFF ** -0.5
    slopes = alibi_slopes(N_DIFF_HEADS)
    kf = k.astype(jnp.float32)
    vf = v.astype(jnp.float32)
    kpos = jnp.arange(S)
    qb = q.astype(jnp.float32).reshape(B, n_blocks, Q_BLOCK, N_DIFF_HEADS, 2, DH_DIFF)
    qb = jnp.moveaxis(qb, 1, 0)

    def one_block(args):
        qblk, i = args
        qpos = i * Q_BLOCK + jnp.arange(Q_BLOCK)
        s = jnp.einsum('bqhcd,bkhcd->bhcqk', qblk, kf) * scale
        dist = qpos[:, None] - kpos[None, :]
        bias = -slopes[:, None, None] * dist.astype(jnp.float32)
        s = s + bias[None, :, None]
        s = jnp.where((dist >= 0)[None, None, None], s, jnp.finfo(jnp.float32).min)
        p = jax.nn.softmax(s, axis=-1)
        a = p[:, :, 0] - lam * p[:, :, 1]
        return jnp.einsum('bhqk,bkhe->bqhe', a, vf)

    out = lax.map(one_block, (qb, jnp.arange(n_blocks)))
    return jnp.moveaxis(out, 0, 1).reshape(B, S, N_DIFF_HEADS, 2 * DH_DIFF)


def multiscale_pool(u, pool_w, pool_scale):
    B, S, _ = u.shape
    uf = u.astype(jnp.float32).reshape(B, S, POOL_GROUPS, POOL_GROUP_WIDTH)
    csum = jnp.cumsum(uf, axis=1)
    cpad = jnp.concatenate([jnp.zeros_like(csum[:, :1]), csum], axis=1)
    t = jnp.arange(S)
    outs = []
    for g, w in enumerate(POOL_WINDOWS):
        lo = jnp.maximum(t + 1 - w, 0)
        window_sum = csum[:, :, g] - cpad[:, lo, g]
        count = jnp.minimum(t + 1, w).astype(jnp.float32)
        outs.append(window_sum / count[None, :, None] - uf[:, :, g])
    p = jnp.stack(outs, axis=2)
    y = jnp.einsum('bsgc,gcd->bsgd', p, pool_w.astype(jnp.float32))
    return (y.reshape(B, S, POOL_WIDTH) * pool_scale.astype(jnp.float32)).astype(u.dtype)


def memory_cross_attention(q, mem_n, w_mem_kv):
    B, S, _ = q.shape
    kv = mem_n @ w_mem_kv
    k_m, v_m = jnp.split(kv, 2, axis=-1)
    qh = q.astype(jnp.float32).reshape(B, S, N_MEM_HEADS, DH_MEM)
    kh = k_m.astype(jnp.float32).reshape(B, -1, N_MEM_HEADS, DH_MEM)
    vh = v_m.astype(jnp.float32).reshape(B, -1, N_MEM_HEADS, DH_MEM)
    s = jnp.einsum('bshd,bmhd->bhsm', qh, kh) * (DH_MEM ** -0.5)
    p = jax.nn.softmax(s, axis=-1)
    o = jnp.einsum('bhsm,bmhd->bshd', p, vh)
    return o.reshape(B, S, MEM_WIDTH).astype(q.dtype)


def causal_depthwise_conv(u, w, b):
    S = u.shape[1]
    up = jnp.pad(u, ((0, 0), (CONV_WIDTH - 1, 0), (0, 0)))
    y = b
    for j in range(CONV_WIDTH):
        y = y + w[j] * up[:, j:j + S]
    return y


def setup_inputs(seed: int = 0) -> dict:
    key = jax.random.key(seed)
    ks = jax.random.split(key, 24)

    def nrm(k, shape, scale):
        return jax.random.normal(k, shape, jnp.float32) * scale

    def gain(k, n):
        return 1.0 + nrm(k, (DEPTH, n), 0.05)

    return {
        "x": nrm(ks[0], (BATCH, SEQ, D_MODEL), 1.0),
        "mem": nrm(ks[1], (BATCH, MEM_TOKENS, D_MODEL), 1.0),
        "norm_mix_pre": gain(ks[2], D_MODEL),
        "w_in": nrm(ks[3], (DEPTH, D_MODEL, IN_COLS), D_MODEL ** -0.5),
        "lambda_q1": nrm(ks[4], (DEPTH, DH_DIFF), 0.1),
        "lambda_k1": nrm(ks[5], (DEPTH, DH_DIFF), 0.1),
        "lambda_q2": nrm(ks[6], (DEPTH, DH_DIFF), 0.1),
        "lambda_k2": nrm(ks[7], (DEPTH, DH_DIFF), 0.1),
        "subln_g": gain(ks[8], 2 * DH_DIFF),
        "w_attn_branch": nrm(ks[9], (DEPTH, DIFF_V_WIDTH, D_MODEL), DIFF_V_WIDTH ** -0.5),
        "pool_w": nrm(ks[10], (DEPTH, POOL_GROUPS, POOL_GROUP_WIDTH, POOL_GROUP_WIDTH), POOL_GROUP_WIDTH ** -0.5),
        "pool_scale": gain(ks[11], POOL_WIDTH),
        "w_pool_branch": nrm(ks[12], (DEPTH, POOL_WIDTH, D_MODEL), POOL_WIDTH ** -0.5),
        "norm_mem": gain(ks[13], D_MODEL),
        "w_mem_kv": nrm(ks[14], (DEPTH, D_MODEL, 2 * MEM_WIDTH), D_MODEL ** -0.5),
        "w_mem_branch": nrm(ks[15], (DEPTH, MEM_WIDTH, D_MODEL), MEM_WIDTH ** -0.5),
        "w_out": nrm(ks[16], (DEPTH, D_MODEL, D_MODEL), D_MODEL ** -0.5),
        "norm_mix_post": gain(ks[17], D_MODEL),
        "norm_ffn_pre": gain(ks[18], D_MODEL),
        "w_up": nrm(ks[19], (DEPTH, D_MODEL, 2 * D_FF), D_MODEL ** -0.5),
        "conv_w": nrm(ks[20], (DEPTH, CONV_WIDTH, 2 * D_FF), CONV_WIDTH ** -0.5),
        "conv_b": nrm(ks[21], (DEPTH, 2 * D_FF), 0.02),
        "w_down": nrm(ks[22], (DEPTH, D_FF, D_MODEL), D_FF ** -0.5),
        "norm_ffn_post": gain(ks[23], D_MODEL),
    }


def reference(x, mem, norm_mix_pre, w_in, lambda_q1, lambda_k1, lambda_q2, lambda_k2, subln_g,
              w_attn_branch, pool_w, pool_scale, w_pool_branch, norm_mem, w_mem_kv, w_mem_branch,
              w_out, norm_mix_post, norm_ffn_pre, w_up, conv_w, conv_b, w_down, norm_ffn_post):
    B, S, D = x.shape
    split_pts = np.cumsum([DIFF_Q_WIDTH, DIFF_Q_WIDTH, DIFF_V_WIDTH, POOL_WIDTH, MEM_WIDTH]).tolist()
    for l in range(DEPTH):
        lam_init = lambda_init_for(l)
        h = rms_norm(x, norm_mix_pre[l])
        proj = h @ w_in[l]
        q_d, k_d, v_d, u_p, q_m, gate_logits = jnp.split(proj, split_pts, axis=-1)

        lam = (jnp.exp(jnp.sum(lambda_q1[l].astype(jnp.float32) * lambda_k1[l].astype(jnp.float32)))
               - jnp.exp(jnp.sum(lambda_q2[l].astype(jnp.float32) * lambda_k2[l].astype(jnp.float32)))
               + lam_init)
        q_d = q_d.reshape(B, S, N_DIFF_HEADS, 2, DH_DIFF)
        k_d = k_d.reshape(B, S, N_DIFF_HEADS, 2, DH_DIFF)
        v_d = v_d.reshape(B, S, N_DIFF_HEADS, 2 * DH_DIFF)
        a = diff_attention(q_d, k_d, v_d, lam)
        a = rms_norm(a, subln_g[l]) * (1.0 - lam_init)
        y_attn = a.reshape(B, S, DIFF_V_WIDTH).astype(x.dtype) @ w_attn_branch[l]

        y_pool = multiscale_pool(u_p, pool_w[l], pool_scale[l]) @ w_pool_branch[l]

        mem_n = rms_norm(mem, norm_mem[l])
        y_mem = memory_cross_attention(q_m, mem_n, w_mem_kv[l]) @ w_mem_branch[l]

        gates = jax.nn.sigmoid(gate_logits.astype(jnp.float32)).reshape(B, S, N_BRANCHES, D).astype(x.dtype)
        mix = gates[:, :, 0] * y_attn + gates[:, :, 1] * y_pool + gates[:, :, 2] * y_mem
        x = x + rms_norm(mix @ w_out[l], norm_mix_post[l])

        h2 = rms_norm(x, norm_ffn_pre[l])
        up = causal_depthwise_conv(h2 @ w_up[l], conv_w[l], conv_b[l])
        g, v = jnp.split(up, 2, axis=-1)
        ff = (jax.nn.gelu(g, approximate=True) * v) @ w_down[l]
        x = x + rms_norm(ff, norm_ffn_post[l])
    return x
```

```cpp
#include <hip/hip_runtime.h>
#include <hip/hip_cooperative_groups.h>
#include <cstdio>
#include <cstdint>
namespace cg = cooperative_groups;

#define LAS __attribute__((address_space(3)))
typedef unsigned short bf16_t;
typedef short bf16x8 __attribute__((ext_vector_type(8)));
typedef float f32x4 __attribute__((ext_vector_type(4)));
typedef unsigned u32x4 __attribute__((ext_vector_type(4)));
typedef unsigned u32x2 __attribute__((ext_vector_type(2)));

constexpr int BATCH = 2, SEQ = 8192, DM = 1024, TOK = BATCH * SEQ;
constexpr int MEMTOK = 256, NMEMH = 4, DHM = 128, MEMW = 512;
constexpr int NH = 8, DHD = 64, DV = 128;
constexpr int POOLW = 512;
constexpr int INC = 7168, DFF = 2816, DFF2 = 5632;
constexpr float EPS = 1e-6f;
constexpr float LOG2E = 1.4426950408889634f;
constexpr float C2Q = 0.125f * LOG2E;
constexpr float C2M = 0.08838834764831845f * LOG2E;
constexpr float LAM_INIT = 0.2f;

constexpr size_t MiB = 1u << 20;
constexpr size_t WS_CTL = 0;
constexpr size_t WS_WIN = 1 * MiB;
constexpr size_t WS_WATT = 15 * MiB;
constexpr size_t WS_WPM = 17 * MiB;
constexpr size_t WS_WMKV = 19 * MiB;
constexpr size_t WS_WOUT = 21 * MiB;
constexpr size_t WS_WUP = 23 * MiB;
constexpr size_t WS_WDN = 34 * MiB;
constexpr size_t WS_MEMN = 40 * MiB;
constexpr size_t WS_KVM = 41 * MiB;
constexpr size_t WS_XN = 42 * MiB;
constexpr size_t WS_V = 74 * MiB;
constexpr size_t WS_UPF = 106 * MiB;
constexpr size_t WS_QM = 122 * MiB;
constexpr size_t WS_AN = 138 * MiB;
constexpr size_t WS_PO = 170 * MiB;
constexpr size_t WS_MIX = 202 * MiB;
constexpr size_t WS_Z = 42 * MiB;
constexpr size_t WS_XN2 = 106 * MiB;
constexpr size_t WS_FF = 138 * MiB;
constexpr size_t WS_END = 234 * MiB;
constexpr int LDS_BYTES = 147456;
constexpr int NTHREADS = 512, NWAVES = 8;

struct Params { const float* in[24]; float* out; unsigned char* ws; };

__device__ __forceinline__ float bf2f(bf16_t v) { return __uint_as_float((unsigned)v << 16); }
__device__ __forceinline__ unsigned f2bf(float f) { unsigned u = __float_as_uint(f); return (u + 0x7fffu + ((u >> 16) & 1u)) >> 16; }
__device__ __forceinline__ unsigned pk2(float lo, float hi) { return f2bf(lo) | (f2bf(hi) << 16); }
__device__ __forceinline__ float wave_sum(float v) {
#pragma unroll
    for (int o = 1; o < 64; o <<= 1) v += __shfl_xor(v, o);
    return v;
}
__device__ __forceinline__ float sigmoidf_(float z) { return 1.0f / (1.0f + __builtin_amdgcn_exp2f(-z * LOG2E)); }
__device__ __forceinline__ float gelu_tanh(float x) {
    const float y = 0.7978845608028654f * (x + 0.044715f * x * x * x);
    return x / (1.0f + __builtin_amdgcn_exp2f(-2.0f * LOG2E * y));
}

template <int MI, int NI>
__device__ __forceinline__ void wave_gemm(const bf16_t* __restrict__ A, int lda, const bf16_t* __restrict__ Bt, int ldb, int K,
                                          int r0, int c0, f32x4 (&acc)[MI][NI], int lane) {
    const int fr = lane & 15, fq = lane >> 4;
    const bf16_t* ap[MI]; const bf16_t* bp[NI];
#pragma unroll
    for (int mi = 0; mi < MI; ++mi) { int r = r0 + 16 * mi + fr; if (r < 0) r = 0; ap[mi] = A + (size_t)r * lda + 8 * fq; }
#pragma unroll
    for (int ni = 0; ni < NI; ++ni) bp[ni] = Bt + (size_t)(c0 + 16 * ni + fr) * ldb + 8 * fq;
#pragma unroll 2
    for (int k0 = 0; k0 < K; k0 += 32) {
        bf16x8 a[MI], b[NI];
#pragma unroll
        for (int mi = 0; mi < MI; ++mi) a[mi] = *(const bf16x8*)(ap[mi] + k0);
#pragma unroll
        for (int ni = 0; ni < NI; ++ni) b[ni] = *(const bf16x8*)(bp[ni] + k0);
#pragma unroll
        for (int mi = 0; mi < MI; ++mi)
#pragma unroll
            for (int ni = 0; ni < NI; ++ni) acc[mi][ni] = __builtin_amdgcn_mfma_f32_16x16x32_bf16(a[mi], b[ni], acc[mi][ni], 0, 0, 0);
    }
}
template <int MI, int NI> __device__ __forceinline__ void zero_acc(f32x4 (&acc)[MI][NI]) {
#pragma unroll
    for (int mi = 0; mi < MI; ++mi)
#pragma unroll
        for (int ni = 0; ni < NI; ++ni) acc[mi][ni] = (f32x4){0.f, 0.f, 0.f, 0.f};
}

struct SrcIn {
    const float* w; const float* g; const float* pw;
    __device__ __forceinline__ float operator()(int k, int n) const {
        const float gk = g[k]; const float* row = w + (size_t)k * INC;
        if (n >= 3072 && n < 3584) { const int grp = (n - 3072) >> 7, d = (n - 3072) & 127; const float* wr = row + 3072 + grp * 128; const float* p = pw + (size_t)grp * 128 * 128 + d;
            float s = 0.f;
            for (int c = 0; c < 128; ++c) s += wr[c] * p[(size_t)c * 128];
            return s * gk; }
        float v = row[n] * gk;
        if (n < 1024) v *= C2Q; else if (n >= 3584 && n < 4096) v *= C2M;
        return v;
    }
};
struct SrcAtt { const float* w; const float* g; __device__ __forceinline__ float operator()(int k, int n) const { return w[(size_t)k * DM + n] * g[k & 127] * (1.0f - LAM_INIT); } };
struct SrcPool { const float* w; const float* g; __device__ __forceinline__ float operator()(int k, int n) const { return w[(size_t)k * DM + n] * g[k]; } };
struct SrcPlain { const float* w; int N; __device__ __forceinline__ float operator()(int k, int n) const { return w[(size_t)k * N + n]; } };
struct SrcGainK { const float* w; const float* g; int N; __device__ __forceinline__ float operator()(int k, int n) const { return w[(size_t)k * N + n] * g[k]; } };
struct SrcUp {
    const float* w; const float* g;
    __device__ __forceinline__ float operator()(int k, int n) const { const int j = n >> 8, s = (n >> 7) & 1, cc = n & 127; return w[(size_t)k * DFF2 + s * DFF + 128 * j + cc] * g[k]; }
};
template <class F>
__device__ __forceinline__ void transpose_item(const F& src, int K, int N, bf16_t* WT, int ldt, int koff, LAS float* scr, int item, int lane) {
    const int nblk = N / 32, kb = item / nblk, nb = item % nblk, k0 = 64 * kb, n0 = 32 * nb;
    for (int i = 0; i < 32; ++i) { const int kk = 2 * i + (lane >> 5); scr[kk * 33 + (lane & 31)] = src(k0 + kk, n0 + (lane & 31)); }
    asm volatile("s_waitcnt lgkmcnt(0)" ::: "memory");
    const int c = lane & 7;
#pragma unroll
    for (int j = 0; j < 4; ++j) { const int n = (lane >> 3) + 8 * j; const LAS float* s = scr + (8 * c) * 33 + n;
        u32x4 o; o.x = pk2(s[0 * 33], s[1 * 33]); o.y = pk2(s[2 * 33], s[3 * 33]); o.z = pk2(s[4 * 33], s[5 * 33]); o.w = pk2(s[6 * 33], s[7 * 33]);
        *(u32x4*)(WT + (size_t)(n0 + n) * ldt + koff + k0 + 8 * c) = o; }
    asm volatile("s_waitcnt lgkmcnt(0)" ::: "memory");
}
__device__ __forceinline__ void rms_row_to_bf16(const float* xrow, bf16_t* orow, int lane) {
    const f32x4* xr = (const f32x4*)xrow + lane; f32x4 v[4]; float s = 0.f;
#pragma unroll
    for (int j = 0; j < 4; ++j) { v[j] = xr[64 * j]; s += (v[j].x * v[j].x + v[j].y * v[j].y) + (v[j].z * v[j].z + v[j].w * v[j].w); }
    const float rstd = 1.0f / sqrtf(wave_sum(s) * (1.0f / DM) + EPS);
    u32x2* o8 = (u32x2*)orow + lane;
#pragma unroll
    for (int j = 0; j < 4; ++j) { u32x2 w; w.x = pk2(v[j].x * rstd, v[j].y * rstd); w.y = pk2(v[j].z * rstd, v[j].w * rstd); o8[64 * j] = w; }
}

__device__ __forceinline__ void phase0(const Params& p, LAS unsigned char* lds, int gw, int NGW, int wave, int lane) {
    LAS float* scr = (LAS float*)(lds + wave * 16384);
    unsigned char* ws = p.ws;
    const SrcIn sIn{p.in[3], p.in[2], p.in[10]};
    const SrcAtt sAtt{p.in[9], p.in[8]};
    const SrcPool sPool{p.in[12], p.in[11]};
    const SrcPlain sMemB{p.in[15], DM};
    const SrcGainK sMkv{p.in[14], p.in[13], DM};
    const SrcPlain sOut{p.in[16], DM};
    const SrcUp sUp{p.in[19], p.in[18]};
    const SrcPlain sDn{p.in[22], DM};
    constexpr int I_IN = (DM / 64) * (INC / 32), I_SQ = (DM / 64) * (DM / 32), I_H = (512 / 64) * (DM / 32), I_UP = (DM / 64) * (DFF2 / 32), I_DN = (DFF / 64) * (DM / 32);
    constexpr int NITEMS = I_IN + I_SQ + 2 * I_H + I_SQ + I_SQ + I_UP + I_DN;
    for (int it = gw; it < NITEMS; it += NGW) {
        int r = it;
        if (r < I_IN) { transpose_item(sIn, DM, INC, (bf16_t*)(ws + WS_WIN), DM, 0, scr, r, lane); continue; } r -= I_IN;
        if (r < I_SQ) { transpose_item(sAtt, DM, DM, (bf16_t*)(ws + WS_WATT), DM, 0, scr, r, lane); continue; } r -= I_SQ;
        if (r < I_H) { transpose_item(sPool, 512, DM, (bf16_t*)(ws + WS_WPM), DM, 0, scr, r, lane); continue; } r -= I_H;
        if (r < I_H) { transpose_item(sMemB, 512, DM, (bf16_t*)(ws + WS_WPM), DM, 512, scr, r, lane); continue; } r -= I_H;
        if (r < I_SQ) { transpose_item(sMkv, DM, DM, (bf16_t*)(ws + WS_WMKV), DM, 0, scr, r, lane); continue; } r -= I_SQ;
        if (r < I_SQ) { transpose_item(sOut, DM, DM, (bf16_t*)(ws + WS_WOUT), DM, 0, scr, r, lane); continue; } r -= I_SQ;
        if (r < I_UP) { transpose_item(sUp, DM, DFF2, (bf16_t*)(ws + WS_WUP), DM, 0, scr, r, lane); continue; } r -= I_UP;
        transpose_item(sDn, DFF, DM, (bf16_t*)(ws + WS_WDN), DFF, 0, scr, r, lane);
    }
    for (int m = gw; m < TOK; m += NGW) rms_row_to_bf16(p.in[0] + (size_t)m * DM, (bf16_t*)(ws + WS_XN) + (size_t)m * DM, lane);
    for (int m = gw; m < BATCH * MEMTOK; m += NGW) rms_row_to_bf16(p.in[1] + (size_t)m * DM, (bf16_t*)(ws + WS_MEMN) + (size_t)m * DM, lane);
}

__device__ __forceinline__ void phase1(const Params& p, int gw, int NGW, int lane) {
    unsigned char* ws = p.ws;
    const bf16_t* xn = (const bf16_t*)(ws + WS_XN); const bf16_t* win = (const bf16_t*)(ws + WS_WIN);
    bf16_t* qb = (bf16_t*)p.out; bf16_t* kb = qb + (size_t)TOK * DM; bf16_t* vb = (bf16_t*)(ws + WS_V);
    bf16_t* upf = (bf16_t*)(ws + WS_UPF); bf16_t* qm = (bf16_t*)(ws + WS_QM);
    const int fr = lane & 15, fq = lane >> 4;
    constexpr int NT1 = (TOK / 32) * (4096 / 32), NT2 = (512 / 32) * (1024 / 32);
    for (int t = gw; t < NT1 + NT2; t += NGW) {
        f32x4 acc[2][2]; zero_acc(acc);
        if (t < NT1) {
            const int mt = t / 128, nt = t % 128, r0 = mt * 32, c0 = nt * 32;
            wave_gemm<2, 2>(xn, DM, win, DM, DM, r0, c0, acc, lane);
            bf16_t* dst; int ld, cc;
            if (c0 < 1024) { dst = qb; ld = DM; cc = c0; } else if (c0 < 2048) { dst = kb; ld = DM; cc = c0 - 1024; } else if (c0 < 3072) { dst = vb; ld = DM; cc = c0 - 2048; }
            else if (c0 < 3584) { dst = upf; ld = 512; cc = c0 - 3072; } else { dst = qm; ld = 512; cc = c0 - 3584; }
#pragma unroll
            for (int mi = 0; mi < 2; ++mi)
#pragma unroll
                for (int ni = 0; ni < 2; ++ni)
#pragma unroll
                    for (int j = 0; j < 4; ++j) dst[(size_t)(r0 + 16 * mi + 4 * fq + j) * ld + cc + 16 * ni + fr] = (bf16_t)f2bf(acc[mi][ni][j]);
        } else {
            const int tt = t - NT1, mt = tt / 32, nt = tt % 32, r0 = mt * 32, c0 = nt * 32;
            wave_gemm<2, 2>((const bf16_t*)(ws + WS_MEMN), DM, (const bf16_t*)(ws + WS_WMKV), DM, DM, r0, c0, acc, lane);
            bf16_t* dst = (bf16_t*)(ws + WS_KVM);
#pragma unroll
            for (int mi = 0; mi < 2; ++mi)
#pragma unroll
                for (int ni = 0; ni < 2; ++ni)
#pragma unroll
                    for (int j = 0; j < 4; ++j) dst[(size_t)(r0 + 16 * mi + 4 * fq + j) * DM + c0 + 16 * ni + fr] = (bf16_t)f2bf(acc[mi][ni][j]);
        }
    }
}

__device__ __forceinline__ float lam_value(const Params& p) {
    float s1 = 0.f, s2 = 0.f;
    for (int i = 0; i < 64; ++i) { s1 += p.in[4][i] * p.in[5][i]; s2 += p.in[6][i] * p.in[7][i]; }
    return expf(s1) - expf(s2) + LAM_INIT;
}
__device__ __forceinline__ void load16(const bf16_t* p, float* o) {
    const u32x4 a = *(const u32x4*)p, b = *(const u32x4*)(p + 8);
    const unsigned w[8] = {a.x, a.y, a.z, a.w, b.x, b.y, b.z, b.w};
#pragma unroll
    for (int i = 0; i < 8; ++i) { o[2 * i] = __uint_as_float(w[i] << 16); o[2 * i + 1] = __uint_as_float(w[i] & 0xffff0000u); }
}
__device__ __forceinline__ void phase2_diff(const Params& p, int gw, int NGW, int lane) {
    unsigned char* ws = p.ws;
    const bf16_t* Q = (const bf16_t*)p.out; const bf16_t* Kb = Q + (size_t)TOK * DM; const bf16_t* Vb = (const bf16_t*)(ws + WS_V);
    bf16_t* an = (bf16_t*)(ws + WS_AN);
    const float lam = lam_value(p);
    const int sub = lane & 3, qi = lane >> 2;
    for (int r = 0; r * NGW + gw < 8192; ++r) {
        const int ig = r * NGW + gw, h = ig & 7, tq = ig >> 3, b = tq >> 9; int tg = tq & 511; if (tg & 256) tg = 767 - tg;
        const int t = tg * 16 + qi; const size_t gm = (size_t)b * SEQ + t;
        const float slope2 = exp2f(-(float)(h + 1)) * LOG2E;
        float o1[32];
        float oo[32];
#pragma unroll
        for (int c = 0; c < 2; ++c) {
            float qv[16]; load16(Q + gm * DM + h * 128 + c * 64 + sub * 16, qv);
            float m = -1e30f, l = 0.f;
#pragma unroll
            for (int e = 0; e < 32; ++e) oo[e] = 0.f;
            const int tmax = tg * 16 + 15;
            const bf16_t* kp = Kb + (size_t)b * SEQ * DM + h * 128 + c * 64 + sub * 16;
            const bf16_t* vp = Vb + (size_t)b * SEQ * DM + h * 128 + sub * 32;
            for (int j = 0; j <= tmax; ++j) {
                float kv[16]; load16(kp + (size_t)j * DM, kv);
                float s = 0.f;
#pragma unroll
                for (int d = 0; d < 16; ++d) s += qv[d] * kv[d];
                s += __shfl_xor(s, 1); s += __shfl_xor(s, 2);
                s -= slope2 * (float)(t - j);
                const bool valid = j <= t;
                const float mn = valid ? fmaxf(m, s) : m;
                const float alpha = __builtin_amdgcn_exp2f(m - mn);
                const float pr = valid ? __builtin_amdgcn_exp2f(s - mn) : 0.f;
                l = l * alpha + pr; m = mn;
                float vv[32]; load16(vp + (size_t)j * DM, vv); load16(vp + (size_t)j * DM + 16, vv + 16);
#pragma unroll
                for (int e = 0; e < 32; ++e) oo[e] = oo[e] * alpha + pr * vv[e];
            }
            const float il = 1.0f / l;
            if (c == 0) {
#pragma unroll
                for (int e = 0; e < 32; ++e) o1[e] = oo[e] * il;
            } else {
#pragma unroll
                for (int e = 0; e < 32; ++e) oo[e] = o1[e] - lam * (oo[e] * il);
            }
        }
        float ss = 0.f;
#pragma unroll
        for (int e = 0; e < 32; ++e) ss += oo[e] * oo[e];
        ss += __shfl_xor(ss, 1); ss += __shfl_xor(ss, 2);
        const float rstd = 1.0f / sqrtf(ss * (1.0f / 128.0f) + EPS);
        bf16_t* dst = an + gm * DM + h * 128 + sub * 32;
#pragma unroll
        for (int e = 0; e < 32; e += 2) *(unsigned*)(dst + e) = pk2(oo[e] * rstd, oo[e + 1] * rstd);
    }
}
__device__ __forceinline__ void phase2_mem(const Params& p, int gw, int NGW, int lane) {
    unsigned char* ws = p.ws;
    const bf16_t* qm = (const bf16_t*)(ws + WS_QM); const bf16_t* kvm = (const bf16_t*)(ws + WS_KVM); bf16_t* po = (bf16_t*)(ws + WS_PO);
    const int sub = lane & 3, qi = lane >> 2;
    for (int ig = gw; ig < (TOK / 16) * NMEMH; ig += NGW) {
        const int h = ig & 3, tq = ig >> 2; const size_t gm = (size_t)tq * 16 + qi; const int b = (int)(gm / SEQ);
        float qv[32]; load16(qm + gm * 512 + h * 128 + sub * 32, qv); load16(qm + gm * 512 + h * 128 + sub * 32 + 16, qv + 16);
        float m = -1e30f, l = 0.f, oo[32];
#pragma unroll
        for (int e = 0; e < 32; ++e) oo[e] = 0.f;
        const bf16_t* kp = kvm + (size_t)b * MEMTOK * DM + h * 128 + sub * 32;
        for (int j = 0; j < MEMTOK; ++j) {
            float kv[32]; load16(kp + (size_t)j * DM, kv); load16(kp + (size_t)j * DM + 16, kv + 16);
            float s = 0.f;
#pragma unroll
            for (int d = 0; d < 32; ++d) s += qv[d] * kv[d];
            s += __shfl_xor(s, 1); s += __shfl_xor(s, 2);
            const float mn = fmaxf(m, s), alpha = __builtin_amdgcn_exp2f(m - mn), pr = __builtin_amdgcn_exp2f(s - mn);
            l = l * alpha + pr; m = mn;
            float vv[32]; load16(kp + (size_t)j * DM + 512, vv); load16(kp + (size_t)j * DM + 512 + 16, vv + 16);
#pragma unroll
            for (int e = 0; e < 32; ++e) oo[e] = oo[e] * alpha + pr * vv[e];
        }
        const float il = 1.0f / l;
        bf16_t* dst = po + gm * DM + 512 + h * 128 + sub * 32;
#pragma unroll
        for (int e = 0; e < 32; e += 2) *(unsigned*)(dst + e) = pk2(oo[e] * il, oo[e + 1] * il);
    }
}
__device__ __forceinline__ void phase2_pool(const Params& p, int gtid, int NGT) {
    unsigned char* ws = p.ws;
    const bf16_t* upf = (const bf16_t*)(ws + WS_UPF); bf16_t* po = (bf16_t*)(ws + WS_PO);
    for (size_t i = gtid; i < (size_t)TOK * 512; i += NGT) {
        const int c = (int)(i & 511); const size_t gm = i >> 9; const int t = (int)(gm & (SEQ - 1)); const int w = 2 << (c >> 7);
        const int lo = t + 1 - w > 0 ? t + 1 - w : 0; const int cnt = t + 1 < w ? t + 1 : w;
        float s = 0.f;
        for (int j = lo; j <= t; ++j) s += bf2f(upf[(gm - t + j) * 512 + c]);
        po[gm * DM + c] = (bf16_t)f2bf(s / (float)cnt - bf2f(upf[gm * 512 + c]));
    }
}

__device__ __forceinline__ void phase3(const Params& p, int gw, int NGW, int lane) {
    unsigned char* ws = p.ws;
    const bf16_t* xn = (const bf16_t*)(ws + WS_XN); const bf16_t* win = (const bf16_t*)(ws + WS_WIN);
    const bf16_t* an = (const bf16_t*)(ws + WS_AN); const bf16_t* po = (const bf16_t*)(ws + WS_PO);
    const bf16_t* watt = (const bf16_t*)(ws + WS_WATT); const bf16_t* wpm = (const bf16_t*)(ws + WS_WPM);
    bf16_t* mix = (bf16_t*)(ws + WS_MIX);
    const int fr = lane & 15, fq = lane >> 4;
    for (int t = gw; t < (TOK / 32) * (DM / 32); t += NGW) {
        const int mt = t / 32, nt = t % 32, r0 = mt * 32, c0 = nt * 32;
        f32x4 mx[2][2]; zero_acc(mx);
#pragma unroll
        for (int i = 0; i < 3; ++i) {
            f32x4 ag[2][2], ay[2][2]; zero_acc(ag); zero_acc(ay);
            wave_gemm<2, 2>(xn, DM, win + (size_t)(4096 + i * 1024) * DM, DM, DM, r0, c0, ag, lane);
            if (i == 0) wave_gemm<2, 2>(an, DM, watt, DM, DM, r0, c0, ay, lane);
            else if (i == 1) wave_gemm<2, 2>(po, DM, wpm, DM, 512, r0, c0, ay, lane);
            else wave_gemm<2, 2>(po + 512, DM, wpm + 512, DM, 512, r0, c0, ay, lane);
#pragma unroll
            for (int mi = 0; mi < 2; ++mi)
#pragma unroll
                for (int ni = 0; ni < 2; ++ni)
#pragma unroll
                    for (int j = 0; j < 4; ++j) mx[mi][ni][j] += sigmoidf_(ag[mi][ni][j]) * ay[mi][ni][j];
        }
#pragma unroll
        for (int mi = 0; mi < 2; ++mi)
#pragma unroll
            for (int ni = 0; ni < 2; ++ni)
#pragma unroll
                for (int j = 0; j < 4; ++j) mix[(size_t)(r0 + 16 * mi + 4 * fq + j) * DM + c0 + 16 * ni + fr] = (bf16_t)f2bf(mx[mi][ni][j]);
    }
}

__device__ __forceinline__ void gemm_f32out(const bf16_t* A, int lda, const bf16_t* Bt, int ldb, int K, int M, int N, float* C, int gw, int NGW, int lane) {
    const int fr = lane & 15, fq = lane >> 4; const int ntn = N / 32;
    for (int t = gw; t < (M / 32) * ntn; t += NGW) {
        const int mt = t / ntn, nt = t % ntn, r0 = mt * 32, c0 = nt * 32;
        f32x4 acc[2][2]; zero_acc(acc);
        wave_gemm<2, 2>(A, lda, Bt, ldb, K, r0, c0, acc, lane);
#pragma unroll
        for (int mi = 0; mi < 2; ++mi)
#pragma unroll
            for (int ni = 0; ni < 2; ++ni)
#pragma unroll
                for (int j = 0; j < 4; ++j) C[(size_t)(r0 + 16 * mi + 4 * fq + j) * N + c0 + 16 * ni + fr] = acc[mi][ni][j];
    }
}
__device__ __forceinline__ void norm_res_rows(const float* z, const float* base, const float* g, float* out, bf16_t* xn2, int gw, int NGW, int lane) {
    for (int m = gw; m < TOK; m += NGW) {
        const f32x4* zr = (const f32x4*)(z + (size_t)m * DM) + lane; const f32x4* br = (const f32x4*)(base + (size_t)m * DM) + lane; const f32x4* gr = (const f32x4*)g + lane;
        f32x4 v[4]; float s = 0.f;
#pragma unroll
        for (int j = 0; j < 4; ++j) { v[j] = zr[64 * j]; s += (v[j].x * v[j].x + v[j].y * v[j].y) + (v[j].z * v[j].z + v[j].w * v[j].w); }
        const float rstd = 1.0f / sqrtf(wave_sum(s) * (1.0f / DM) + EPS);
        float s2 = 0.f;
#pragma unroll
        for (int j = 0; j < 4; ++j) { v[j] = br[64 * j] + v[j] * rstd * gr[64 * j]; s2 += (v[j].x * v[j].x + v[j].y * v[j].y) + (v[j].z * v[j].z + v[j].w * v[j].w); }
        f32x4* orow = (f32x4*)(out + (size_t)m * DM) + lane;
#pragma unroll
        for (int j = 0; j < 4; ++j) orow[64 * j] = v[j];
        if (xn2) {
            const float r2 = 1.0f / sqrtf(wave_sum(s2) * (1.0f / DM) + EPS);
            u32x2* o8 = (u32x2*)(xn2 + (size_t)m * DM) + lane;
#pragma unroll
            for (int j = 0; j < 4; ++j) { u32x2 w; w.x = pk2(v[j].x * r2, v[j].y * r2); w.y = pk2(v[j].z * r2, v[j].w * r2); o8[64 * j] = w; }
        }
    }
}

__device__ __forceinline__ void phase5(const Params& p, LAS unsigned char* lds, int gw, int NGW, int wave, int lane) {
    unsigned char* ws = p.ws;
    const bf16_t* xn2 = (const bf16_t*)(ws + WS_XN2); const bf16_t* wup = (const bf16_t*)(ws + WS_WUP); bf16_t* ff = (bf16_t*)(ws + WS_FF);
    const float* cw = p.in[20]; const float* cb = p.in[21];
    LAS float* scr = (LAS float*)(lds + wave * 16384);
    const int fr = lane & 15, fq = lane >> 4;
    for (int t = gw; t < (TOK / 32) * (DFF / 32); t += NGW) {
        const int mt = t / 88, ct = t % 88, m0 = mt * 32, ch0 = ct * 32;
        const int grow = 256 * (ch0 >> 7) + (ch0 & 127);
        f32x4 ag[3][2], av[3][2]; zero_acc(ag); zero_acc(av);
        wave_gemm<3, 2>(xn2, DM, wup, DM, DM, m0 - 16, grow, ag, lane);
        wave_gemm<3, 2>(xn2, DM, wup, DM, DM, m0 - 16, grow + 128, av, lane);
#pragma unroll
        for (int mi = 0; mi < 3; ++mi)
#pragma unroll
            for (int ni = 0; ni < 2; ++ni)
#pragma unroll
                for (int j = 0; j < 4; ++j) { const int rr = 16 * mi + 4 * fq + j; scr[rr * 64 + 16 * ni + fr] = ag[mi][ni][j]; scr[rr * 64 + 32 + 16 * ni + fr] = av[mi][ni][j]; }
        asm volatile("s_waitcnt lgkmcnt(0)" ::: "memory");
        const int c = lane & 31, ch = ch0 + c;
        const float wg0 = cw[ch], wg1 = cw[DFF2 + ch], wg2 = cw[2 * DFF2 + ch], bg = cb[ch];
        const float wv0 = cw[DFF + ch], wv1 = cw[DFF2 + DFF + ch], wv2 = cw[2 * DFF2 + DFF + ch], bv = cb[DFF + ch];
        for (int i = 0; i < 16; ++i) {
            const int r = (lane >> 5) + 2 * i, m = m0 + r, tt = m & (SEQ - 1);
            const float g2 = scr[(16 + r) * 64 + c], g1 = tt >= 1 ? scr[(15 + r) * 64 + c] : 0.f, g0 = tt >= 2 ? scr[(14 + r) * 64 + c] : 0.f;
            const float v2 = scr[(16 + r) * 64 + 32 + c], v1 = tt >= 1 ? scr[(15 + r) * 64 + 32 + c] : 0.f, v0 = tt >= 2 ? scr[(14 + r) * 64 + 32 + c] : 0.f;
            const float cgv = bg + wg0 * g0 + wg1 * g1 + wg2 * g2, cvv = bv + wv0 * v0 + wv1 * v1 + wv2 * v2;
            ff[(size_t)m * DFF + ch] = (bf16_t)f2bf(gelu_tanh(cgv) * cvv);
        }
        asm volatile("s_waitcnt lgkmcnt(0)" ::: "memory");
    }
}

__global__ void __launch_bounds__(NTHREADS) mega_fwd(Params p) {
    extern __shared__ __attribute__((aligned(16))) unsigned char lds_raw[];
    LAS unsigned char* lds = (LAS unsigned char*)lds_raw;
    cg::grid_group grid = cg::this_grid();
    const int tid = threadIdx.x, lane = tid & 63, wave = tid >> 6;
    const int G = gridDim.x, gw = blockIdx.x * NWAVES + wave, NGW = G * NWAVES;
    unsigned char* ws = p.ws;

    phase0(p, lds, gw, NGW, wave, lane);
    grid.sync();
    phase1(p, gw, NGW, lane);
    grid.sync();
    phase2_diff(p, gw, NGW, lane);
    phase2_mem(p, gw, NGW, lane);
    phase2_pool(p, blockIdx.x * NTHREADS + tid, G * NTHREADS);
    grid.sync();
    phase3(p, gw, NGW, lane);
    grid.sync();
    gemm_f32out((const bf16_t*)(ws + WS_MIX), DM, (const bf16_t*)(ws + WS_WOUT), DM, DM, TOK, DM, (float*)(ws + WS_Z), gw, NGW, lane);
    grid.sync();
    norm_res_rows((const float*)(ws + WS_Z), p.in[0], p.in[17], p.out, (bf16_t*)(ws + WS_XN2), gw, NGW, lane);
    grid.sync();
    phase5(p, lds, gw, NGW, wave, lane);
    grid.sync();
    gemm_f32out((const bf16_t*)(ws + WS_FF), DFF, (const bf16_t*)(ws + WS_WDN), DFF, DFF, TOK, DM, (float*)(ws + WS_Z), gw, NGW, lane);
    grid.sync();
    norm_res_rows((const float*)(ws + WS_Z), p.out, p.in[23], p.out, nullptr, gw, NGW, lane);
}

extern "C" void kernel_launch(void* const* d_in, const int* in_sizes, int n_in, void* d_out, int out_size, void* d_ws, size_t ws_size, hipStream_t stream) {
    static int grid = 0;
    if (grid == 0) {
        if (n_in != 24 || out_size != TOK * DM || ws_size < WS_END) { fprintf(stderr, "kernel_launch: unexpected shapes (n_in %d out %d ws %zu)\n", n_in, out_size, ws_size); grid = -1; return; }
        int dev = 0, cus = 0, per_cu = 0;
        (void)hipGetDevice(&dev); (void)hipDeviceGetAttribute(&cus, hipDeviceAttributeMultiprocessorCount, dev);
        (void)hipFuncSetAttribute((const void*)mega_fwd, hipFuncAttributeMaxDynamicSharedMemorySize, LDS_BYTES);
        if (hipOccupancyMaxActiveBlocksPerMultiprocessor(&per_cu, (const void*)mega_fwd, NTHREADS, LDS_BYTES) != hipSuccess || per_cu < 1) per_cu = 1;
        grid = cus * per_cu;
        if (grid <= 0) grid = 256;
    }
    if (grid < 0) return;
    Params p{};
    for (int i = 0; i < 24; ++i) p.in[i] = (const float*)d_in[i];
    p.out = (float*)d_out; p.ws = (unsigned char*)d_ws;
    void* args[] = {&p};
    hipError_t e = hipLaunchCooperativeKernel((const void*)mega_fwd, dim3(grid), dim3(NTHREADS), args, LDS_BYTES, stream);
    if (e != hipSuccess) fprintf(stderr, "cooperative launch failed: %s (grid %d)\n", hipGetErrorString(e), grid);
}
```

```cpp
#include <hip/hip_runtime.h>
#include <hip/hip_cooperative_groups.h>
#include <cstdio>
#include <cstdint>
namespace cg = cooperative_groups;

#define LAS __attribute__((address_space(3)))
typedef unsigned short bf16_t;
typedef short bf16x8 __attribute__((ext_vector_type(8)));
typedef float f32x4 __attribute__((ext_vector_type(4)));
typedef unsigned u32x4 __attribute__((ext_vector_type(4)));
typedef unsigned u32x2 __attribute__((ext_vector_type(2)));

constexpr int BATCH = 2, SEQ = 8192, DM = 1024, TOK = BATCH * SEQ;
constexpr int MEMTOK = 256, NMEMH = 4, DHM = 128, MEMW = 512;
constexpr int NH = 8, DHD = 64, DV = 128;
constexpr int POOLW = 512;
constexpr int INC = 7168, DFF = 2816, DFF2 = 5632;
constexpr float EPS = 1e-6f;
constexpr float LOG2E = 1.4426950408889634f;
constexpr float C2Q = 0.125f * LOG2E;
constexpr float C2M = 0.08838834764831845f * LOG2E;
constexpr float LAM_INIT = 0.2f;

constexpr size_t MiB = 1u << 20;
constexpr size_t WS_CTL = 0;
constexpr size_t WS_WIN = 1 * MiB;
constexpr size_t WS_WATT = 15 * MiB;
constexpr size_t WS_WPM = 17 * MiB;
constexpr size_t WS_WMKV = 19 * MiB;
constexpr size_t WS_WOUT = 21 * MiB;
constexpr size_t WS_WUP = 23 * MiB;
constexpr size_t WS_WDN = 34 * MiB;
constexpr size_t WS_MEMN = 40 * MiB;
constexpr size_t WS_KVM = 41 * MiB;
constexpr size_t WS_XN = 42 * MiB;
constexpr size_t WS_V = 74 * MiB;
constexpr size_t WS_UPF = 106 * MiB;
constexpr size_t WS_QM = 122 * MiB;
constexpr size_t WS_AN = 138 * MiB;
constexpr size_t WS_PO = 170 * MiB;
constexpr size_t WS_MIX = 202 * MiB;
constexpr size_t WS_Z = 42 * MiB;
constexpr size_t WS_XN2 = 106 * MiB;
constexpr size_t WS_FF = 138 * MiB;
constexpr size_t WS_END = 234 * MiB;
constexpr int LDS_BYTES = 147456;
constexpr int NTHREADS = 512, NWAVES = 8;

struct Params { const float* in[24]; float* out; unsigned char* ws; };

__device__ __forceinline__ float bf2f(bf16_t v) { return __uint_as_float((unsigned)v << 16); }
__device__ __forceinline__ unsigned f2bf(float f) { unsigned u = __float_as_uint(f); return (u + 0x7fffu + ((u >> 16) & 1u)) >> 16; }
__device__ __forceinline__ unsigned pk2(float lo, float hi) { return f2bf(lo) | (f2bf(hi) << 16); }
__device__ __forceinline__ float wave_sum(float v) {
#pragma unroll
    for (int o = 1; o < 64; o <<= 1) v += __shfl_xor(v, o);
    return v;
}
__device__ __forceinline__ float sigmoidf_(float z) { return 1.0f / (1.0f + __builtin_amdgcn_exp2f(-z * LOG2E)); }
__device__ __forceinline__ float gelu_tanh(float x) {
    const float y = 0.7978845608028654f * (x + 0.044715f * x * x * x);
    return x / (1.0f + __builtin_amdgcn_exp2f(-2.0f * LOG2E * y));
}

template <int MI, int NI>
__device__ __forceinline__ void wave_gemm(const bf16_t* __restrict__ A, int lda, const bf16_t* __restrict__ Bt, int ldb, int K,
                                          int r0, int c0, f32x4 (&acc)[MI][NI], int lane) {
    const int fr = lane & 15, fq = lane >> 4;
    const bf16_t* ap[MI]; const bf16_t* bp[NI];
#pragma unroll
    for (int mi = 0; mi < MI; ++mi) { int r = r0 + 16 * mi + fr; if (r < 0) r = 0; ap[mi] = A + (size_t)r * lda + 8 * fq; }
#pragma unroll
    for (int ni = 0; ni < NI; ++ni) bp[ni] = Bt + (size_t)(c0 + 16 * ni + fr) * ldb + 8 * fq;
#pragma unroll 2
    for (int k0 = 0; k0 < K; k0 += 32) {
        bf16x8 a[MI], b[NI];
#pragma unroll
        for (int mi = 0; mi < MI; ++mi) a[mi] = *(const bf16x8*)(ap[mi] + k0);
#pragma unroll
        for (int ni = 0; ni < NI; ++ni) b[ni] = *(const bf16x8*)(bp[ni] + k0);
#pragma unroll
        for (int mi = 0; mi < MI; ++mi)
#pragma unroll
            for (int ni = 0; ni < NI; ++ni) acc[mi][ni] = __builtin_amdgcn_mfma_f32_16x16x32_bf16(a[mi], b[ni], acc[mi][ni], 0, 0, 0);
    }
}
template <int MI, int NI> __device__ __forceinline__ void zero_acc(f32x4 (&acc)[MI][NI]) {
#pragma unroll
    for (int mi = 0; mi < MI; ++mi)
#pragma unroll
        for (int ni = 0; ni < NI; ++ni) acc[mi][ni] = (f32x4){0.f, 0.f, 0.f, 0.f};
}


namespace pg8 {
#define PG8_LAS __attribute__((address_space(3)))
constexpr int BM = 256, BK = 64, HALF = 128, HTB = HALF * BK * 2  , STAGE_BYTES = 8 * HTB, NXCD = 8, WGM = 8;
__host__ __device__ __forceinline__ int lds_byte(int r, int c) { const int st = (r >> 4) * 2 + (c >> 5), rr = r & 15, cc = c & 31, ob = rr * 64 + cc * 2; return st * 1024 + (ob ^ (((ob >> 9) & 1) << 5)); }
__host__ __device__ __forceinline__ void stage_rc(int b, int& R, int& C) { const int st = b / 1024, sb = b % 1024, swz = sb ^ (((sb >> 9) & 1) << 5); R = (st >> 1) * 16 + swz / 64; C = (st & 1) * 32 + (swz % 64) / 2; }
__host__ __device__ __forceinline__ int perm32(int rho) { const int n = rho >> 4, i = rho & 15; return 8 * (i >> 2) + 4 * n + (i & 3); }
__device__ __forceinline__ unsigned cvt_pk_bf16(float lo, float hi) { unsigned r; asm volatile("v_cvt_pk_bf16_f32 %0, %1, %2" : "=v"(r) : "v"(lo), "v"(hi)); return r; }

struct Unit { int pm, pn, kind; };
struct Ops { const char* a; const char* b; int nt; };

struct StaticOrder {
    int nM, nN, nwg, G, c;
    __host__ __device__ void init(int M, int N, int G_, int c_) { nM = M / BM; nN = N / BM; nwg = nM * nN; G = G_; c = c_; }
    __host__ __device__ bool next(int i, Unit& u) const {
        const long L = (long)i * G + c; if (L >= nwg) return false;
        int wgid = (int)L; { const int q = nwg / NXCD, r = nwg % NXCD, xcd = wgid % NXCD, off = wgid / NXCD; wgid = (xcd < r ? xcd * (q + 1) : r * (q + 1) + (xcd - r) * q) + off; }
        const int nig = WGM * nN, gid = wgid / nig, fm = gid * WGM, gsz = (nM - fm) < WGM ? (nM - fm) : WGM;
        u.pm = fm + ((wgid % nig) % gsz); u.pn = (wgid % nig) / gsz; u.kind = 0; return true;
    }
};
struct SchedStd : StaticOrder {
    const bf16_t* A; const bf16_t* Bt; int K;
    __device__ __forceinline__ Ops ops(const Unit& u) const { Ops o; o.a = (const char*)(A + (size_t)u.pm * BM * K); o.b = (const char*)(Bt + (size_t)u.pn * BM * K); o.nt = K / BK; return o; }
};

struct EpiF32 {
    static constexpr bool PERM = false;
    float* C; int ldc;
    __device__ __forceinline__ void operator()(const f32x4 (&acc)[2][2][4][2], const Unit& u, int wr, int wc, int fr, int fq) const {
        const int row0 = u.pm * BM + wr * 64 + fr, col0 = u.pn * BM + wc * 32 + 4 * fq;
#pragma unroll
        for (int ai = 0; ai < 2; ++ai)
#pragma unroll
            for (int m = 0; m < 4; ++m) { float* rowp = C + (size_t)(row0 + ai * HALF + m * 16) * ldc + col0;
#pragma unroll
                for (int bj = 0; bj < 2; ++bj)
#pragma unroll
                    for (int n = 0; n < 2; ++n) *(f32x4*)(rowp + bj * HALF + n * 16) = acc[ai][bj][m][n]; }
    }
};
__device__ __forceinline__ void store_tile_bf16(const f32x4 (&acc)[2][2][4][2], bf16_t* base, int ldc, int row0, int col0) {
#pragma unroll
    for (int ai = 0; ai < 2; ++ai)
#pragma unroll
        for (int m = 0; m < 4; ++m) { bf16_t* rowp = base + (size_t)(row0 + ai * HALF + m * 16) * ldc + col0;
#pragma unroll
            for (int bj = 0; bj < 2; ++bj) { const f32x4 v0 = acc[ai][bj][m][0], v1 = acc[ai][bj][m][1];
                u32x4 w; w.x = cvt_pk_bf16(v0[0], v0[1]); w.y = cvt_pk_bf16(v0[2], v0[3]); w.z = cvt_pk_bf16(v1[0], v1[1]); w.w = cvt_pk_bf16(v1[2], v1[3]);
                *(u32x4*)(rowp + bj * HALF) = w; } }
}
struct EpiBf16Plain {
    static constexpr bool PERM = true;
    bf16_t* O; int ldc;
    __device__ __forceinline__ void operator()(const f32x4 (&acc)[2][2][4][2], const Unit& u, int wr, int wc, int fr, int fq) const {
        store_tile_bf16(acc, O, ldc, u.pm * BM + wr * 64 + fr, u.pn * BM + wc * 32 + 8 * fq);
    }
};
struct EpiP1 {
    static constexpr bool PERM = true;
    bf16_t* q; bf16_t* k; bf16_t* v; bf16_t* upf; bf16_t* qm;
    __device__ __forceinline__ void operator()(const f32x4 (&acc)[2][2][4][2], const Unit& u, int wr, int wc, int fr, int fq) const {
        const int pn = u.pn; bf16_t* base; int ldc, colt;
        if (pn < 4) { base = q; ldc = 1024; colt = pn * 256; } else if (pn < 8) { base = k; ldc = 1024; colt = (pn - 4) * 256; } else if (pn < 12) { base = v; ldc = 1024; colt = (pn - 8) * 256; }
        else if (pn < 14) { base = upf; ldc = 512; colt = (pn - 12) * 256; } else { base = qm; ldc = 512; colt = (pn - 14) * 256; }
        store_tile_bf16(acc, base, ldc, u.pm * BM + wr * 64 + fr, colt + wc * 32 + 8 * fq);
    }
};

template <class Epi, class Sched, bool ALIGN_EPI>
__device__ __forceinline__ void gemm_phase(PG8_LAS unsigned char* lds, const int ld, const Sched& S, const Epi& E) {
    const int tid = threadIdx.x, wid = __builtin_amdgcn_readfirstlane(tid >> 6), lane = tid & 63, wr = wid >> 2, wc = wid & 3, fr = lane & 15, fq = lane >> 4;
    unsigned voffA[2], voffB[2];
#pragma unroll
    for (int i = 0; i < 2; ++i) { int R, C; stage_rc(tid * 16 + i * 8192, R, C); const int Rb = Epi::PERM ? ((R & ~31) + perm32(R & 31)) : R;
        voffA[i] = (unsigned)(R * ld + C) * 2u; voffB[i] = (unsigned)(Rb * ld + C) * 2u; }
    const size_t kstep = (size_t)(BK * 2);
    const size_t hstep = (size_t)HALF * ld * 2;
    const unsigned ldsw = (unsigned)wid * 1024u;
    const int aoff = lds_byte(wr * 64 + fr, fq * 8), boff = lds_byte(wc * 32 + fr, fq * 8);
#define PG8_SA(b, h) (((b) * 2 + (h)) * HTB)
#define PG8_SB(b, h) ((4 + (b) * 2 + (h)) * HTB)
#define PG8_STAGE(bufoff, gbase, voff) do { _Pragma("unroll") for (int _i = 0; _i < 2; ++_i) \
        __builtin_amdgcn_global_load_lds((const unsigned*)((const char*)(gbase) + (voff)[_i]), (PG8_LAS unsigned*)(lds + (bufoff) + ldsw + _i * 8192), 16, 0, 0); } while (0)
#define PG8_LDA(dst, b, h) do { _Pragma("unroll") for (int m = 0; m < 4; ++m) _Pragma("unroll") for (int k = 0; k < 2; ++k) dst[m][k] = *(const PG8_LAS bf16x8*)(lds + PG8_SA(b, h) + aoff + m * 2048 + k * 1024); } while (0)
#define PG8_LDB(dst, b, h) do { _Pragma("unroll") for (int n = 0; n < 2; ++n) _Pragma("unroll") for (int k = 0; k < 2; ++k) dst[n][k] = *(const PG8_LAS bf16x8*)(lds + PG8_SB(b, h) + boff + n * 2048 + k * 1024); } while (0)
#define PG8_MMA(ai, bj, At, Bt) do { __builtin_amdgcn_s_setprio(1); _Pragma("unroll") for (int m = 0; m < 4; ++m) _Pragma("unroll") for (int n = 0; n < 2; ++n) _Pragma("unroll") for (int k = 0; k < 2; ++k) \
        acc[ai][bj][m][n] = __builtin_amdgcn_mfma_f32_16x16x32_bf16(Bt[n][k], At[m][k], acc[ai][bj][m][n], 0, 0, 0); __builtin_amdgcn_s_setprio(0); } while (0)
#define PG8_WAIT_V(n) asm volatile("s_waitcnt vmcnt(" #n ")" ::: "memory")
#define PG8_WAIT_L(n) asm volatile("s_waitcnt lgkmcnt(" #n ")" ::: "memory")
#define PG8_BAR __builtin_amdgcn_s_barrier()
#define PG8_SCHED __builtin_amdgcn_sched_barrier(0)
    Unit cur, nxt; int ui = 0;
    if (!S.next(0, cur)) return;
    Ops oc = S.ops(cur);
    f32x4 acc[2][2][4][2];
#pragma unroll
    for (int a = 0; a < 2; ++a)
#pragma unroll
        for (int b = 0; b < 2; ++b)
#pragma unroll
            for (int m = 0; m < 4; ++m)
#pragma unroll
                for (int n = 0; n < 2; ++n) acc[a][b][m][n] = (f32x4){0.f, 0.f, 0.f, 0.f};
    bf16x8 At[4][2], B0[2][2], B1[2][2];
    const char* cA = oc.a; const char* cB = oc.b; int nt = oc.nt;
    PG8_STAGE(PG8_SB(0, 0), cB, voffB); PG8_STAGE(PG8_SB(0, 1), cB + hstep, voffB); PG8_STAGE(PG8_SA(0, 0), cA, voffA); PG8_STAGE(PG8_SA(0, 1), cA + hstep, voffA);
    if (wr == 1) PG8_BAR;
    PG8_WAIT_V(2); PG8_BAR;
    PG8_STAGE(PG8_SB(1, 0), cB + kstep, voffB); PG8_STAGE(PG8_SA(1, 0), cA + kstep, voffA); PG8_STAGE(PG8_SB(1, 1), cB + hstep + kstep, voffB);
    PG8_WAIT_V(6); PG8_BAR;
    for (;;) {
        const bool has_next = S.next(ui + 1, nxt);
        Ops on = oc; if (has_next) on = S.ops(nxt);
        const char* nA = on.a; const char* nB = on.b;
        for (int t = 0; t < nt; t += 2) {
            const bool last = (t == nt - 2);
            const char* a1 = cA + (size_t)(t + 1) * kstep;
            const char* a2 = last ? nA : cA + (size_t)(t + 2) * kstep; const char* b2 = last ? nB : cB + (size_t)(t + 2) * kstep;
            const char* a3 = a2 + kstep; const char* b3 = b2 + kstep;
            PG8_LDB(B0, 0, 0); PG8_LDB(B1, 0, 1); PG8_SCHED; PG8_LDA(At, 0, 0); PG8_STAGE(PG8_SA(1, 1), a1 + hstep, voffA);
            PG8_WAIT_V(8); PG8_WAIT_L(0); PG8_BAR; PG8_MMA(0, 0, At, B0); PG8_MMA(0, 1, At, B1); PG8_BAR; PG8_SCHED;
            PG8_LDA(At, 0, 1); PG8_STAGE(PG8_SB(0, 0), b2, voffB); PG8_STAGE(PG8_SB(0, 1), b2 + hstep, voffB); PG8_STAGE(PG8_SA(0, 0), a2, voffA);
            PG8_WAIT_V(8); PG8_WAIT_L(0); PG8_BAR; PG8_MMA(1, 0, At, B0); PG8_MMA(1, 1, At, B1); PG8_BAR; PG8_SCHED;
            PG8_LDB(B0, 1, 0); PG8_LDB(B1, 1, 1); PG8_SCHED; PG8_LDA(At, 1, 0); PG8_STAGE(PG8_SA(0, 1), a2 + hstep, voffA);
            PG8_WAIT_V(8); PG8_WAIT_L(0); PG8_BAR; PG8_MMA(0, 0, At, B0); PG8_MMA(0, 1, At, B1); PG8_BAR; PG8_SCHED;
            PG8_LDA(At, 1, 1); PG8_STAGE(PG8_SB(1, 0), b3, voffB); PG8_STAGE(PG8_SB(1, 1), b3 + hstep, voffB); PG8_STAGE(PG8_SA(1, 0), a3, voffA);
            PG8_WAIT_V(8); PG8_WAIT_L(0); PG8_BAR; PG8_MMA(1, 0, At, B0); PG8_MMA(1, 1, At, B1); PG8_BAR; PG8_SCHED;
        }
        if constexpr (ALIGN_EPI) { if (wr == 0) PG8_BAR; }
        E(acc, cur, wr, wc, fr, fq);
        if (!has_next) break;
#pragma unroll
        for (int a = 0; a < 2; ++a)
#pragma unroll
            for (int b = 0; b < 2; ++b)
#pragma unroll
                for (int m = 0; m < 4; ++m)
#pragma unroll
                    for (int n = 0; n < 2; ++n) acc[a][b][m][n] = (f32x4){0.f, 0.f, 0.f, 0.f};
        cur = nxt; oc = on; cA = nA; cB = nB; nt = on.nt; ++ui;
        if constexpr (ALIGN_EPI) { if (wr == 1) PG8_BAR; }
    }
    PG8_WAIT_V(0);
    if constexpr (!ALIGN_EPI) { if (wr == 0) PG8_BAR; }
    PG8_BAR;
#undef PG8_SA
#undef PG8_SB
#undef PG8_STAGE
#undef PG8_LDA
#undef PG8_LDB
#undef PG8_MMA
#undef PG8_WAIT_V
#undef PG8_WAIT_L
#undef PG8_BAR
#undef PG8_SCHED
}
}


namespace dat {
typedef short s16x4 __attribute__((ext_vector_type(4)));
typedef float f32x16 __attribute__((ext_vector_type(16)));
constexpr int NW = 8, QBLK = 32, KVBLK = 64, QB = NW * QBLK, PITCH = 1024;
constexpr int SHM_V = KVBLK * 128 * 2, SHM_K = KVBLK * 64 * 2;
constexpr int LDS_USED = 2 * SHM_V + 2 * SHM_K + NW * 64 * 4;
constexpr float THR = 8.f;
#define KSWZ(row, colB) ((row) * 128 + ((colB) ^ ((((row) >> 1) & 7) << 4)))
#define SBAR() __builtin_amdgcn_sched_barrier(0)
__device__ __forceinline__ int v_st(int k, int c) { const int kk = (k & ~0xC) | ((k & 4) << 1) | ((k & 8) >> 1); return ((kk >> 3) * 4 + (c >> 5)) * 512 + ((kk & 7) * 32 + (c & 31)) * 2; }
__device__ __forceinline__ int v_rd_base(int lane) { return ((lane & 3) << 3) | (((lane >> 2) & 3) << 6) | (((lane >> 4) & 1) << 5) | (((lane >> 5) & 1) << 8); }
constexpr int v_rd_off(int d0, int ks, int half) { return d0 * 512 + ks * 4096 + half * 2048; }
__device__ __forceinline__ int crow(int r, int hi) { return (r & 3) + 8 * (r >> 2) + 4 * hi; }
__device__ __forceinline__ unsigned cvtpk(float lo, float hi) { unsigned r; asm volatile("v_cvt_pk_bf16_f32 %0, %1, %2" : "=v"(r) : "v"(lo), "v"(hi)); return r; }

__device__ __forceinline__ void mask_tile(f32x16& p0, f32x16& p1, int dq) {
    const float NEG = -__builtin_inff();
#pragma unroll
    for (int r = 0; r < 16; ++r) { const int c = (r & 3) + 8 * (r >> 2); if (dq - c < 0) p0[r] = NEG; if (dq - c - 32 < 0) p1[r] = NEG; }
}
__device__ __forceinline__ void partialSM(f32x16& p0, f32x16& p1, float& m_reg, float& alpha) {
    float pmax = p0[0];
#pragma unroll
    for (int r = 1; r < 16; ++r) pmax = fmaxf(pmax, p0[r]);
#pragma unroll
    for (int r = 0; r < 16; ++r) pmax = fmaxf(pmax, p1[r]);
    { auto rr = __builtin_amdgcn_permlane32_swap(__float_as_uint(pmax), __float_as_uint(pmax), false, false);
      pmax = fmaxf(__uint_as_float(rr[0]), __uint_as_float(rr[1])); }
    float mn;
    if (__builtin_expect(__all(pmax - m_reg <= THR), 1)) { mn = m_reg; alpha = 1.f; }
    else { mn = fmaxf(m_reg, pmax); alpha = __builtin_amdgcn_exp2f(m_reg - mn); m_reg = mn; }
#pragma unroll
    for (int r = 0; r < 16; ++r) p0[r] = p0[r] - mn;
#pragma unroll
    for (int r = 0; r < 16; ++r) p1[r] = p1[r] - mn;
#pragma unroll
    for (int r = 0; r < 16; ++r) p0[r] = __builtin_amdgcn_exp2f(p0[r]);
}
__device__ __forceinline__ void finishSM(f32x16& p0, f32x16& p1, float alpha, float& l_reg, bf16x8& pa0, bf16x8& pa1, bf16x8& pa2, bf16x8& pa3) {
#pragma unroll
    for (int r = 0; r < 16; ++r) p1[r] = __builtin_amdgcn_exp2f(p1[r]);
    float ps = 0;
#pragma unroll
    for (int r = 0; r < 16; ++r) ps += p0[r];
#pragma unroll
    for (int r = 0; r < 16; ++r) ps += p1[r];
    { auto rr = __builtin_amdgcn_permlane32_swap(__float_as_uint(ps), __float_as_uint(ps), false, false);
      ps = __uint_as_float(rr[0]) + __uint_as_float(rr[1]); }
    l_reg = l_reg * alpha + ps;
#define PK4(P, B_, OUT) do { unsigned a0 = cvtpk(P[B_+0], P[B_+1]), a1 = cvtpk(P[B_+2], P[B_+3]);                          \
        unsigned b0 = cvtpk(P[B_+4], P[B_+5]), b1 = cvtpk(P[B_+6], P[B_+7]);                                             \
        auto r0 = __builtin_amdgcn_permlane32_swap(a0, b0, false, false); auto r1 = __builtin_amdgcn_permlane32_swap(a1, b1, false, false); \
        u32x4 w = {r0[0], r1[0], r0[1], r1[1]}; OUT = *reinterpret_cast<bf16x8*>(&w); } while (0)
    PK4(p0, 0, pa0); PK4(p0, 8, pa1); PK4(p1, 0, pa2); PK4(p1, 8, pa3);
#undef PK4
}
template <int KB>
__device__ __forceinline__ void qkt(f32x16& p0, f32x16& p1, const char* K_lds, int r32, int hi, const bf16x8* qr, float slope2, float off0) {
    const float off1 = off0 + 32.f * slope2;
#pragma unroll
    for (int r = 0; r < 16; ++r) { const float c = (float)((r & 3) + 8 * (r >> 2)); p0[r] = fmaf(slope2, c, off0); p1[r] = fmaf(slope2, c, off1); }
    const char* kb[4];
#pragma unroll
    for (int d0 = 0; d0 < 4; ++d0) kb[d0] = K_lds + KB * SHM_K + KSWZ(r32, (d0 * 16 + hi * 8) * 2);
#pragma unroll
    for (int d0 = 0; d0 < 4; ++d0) {
        bf16x8 b0 = *reinterpret_cast<const bf16x8*>(kb[d0]);
        bf16x8 b1 = *reinterpret_cast<const bf16x8*>(kb[d0] + 32 * 128);
        p0 = __builtin_amdgcn_mfma_f32_32x32x16_bf16(b0, qr[d0], p0, 0, 0, 0);
        p1 = __builtin_amdgcn_mfma_f32_32x32x16_bf16(b1, qr[d0], p1, 0, 0, 0); }
}
template <int VB>
__device__ __forceinline__ void pv_tile(f32x16* o, int vb0, bf16x8 pa0, bf16x8 pa1, bf16x8 pa2, bf16x8 pa3) {
#define TRRD(dst, off) asm volatile("ds_read_b64_tr_b16 %0, %1 offset:%2" : "=&v"(dst) : "v"(vb0), "i"(off) : "memory")
#define PV_D0(d0) do { s16x4 l0, l1, l2, l3, h0, h1, h2, h3; constexpr int b_ = VB * SHM_V + v_rd_off(d0, 0, 0);   \
        TRRD(l0, b_); TRRD(h0, b_ + 2048); TRRD(l1, b_ + 4096); TRRD(h1, b_ + 6144); TRRD(l2, b_ + 8192); TRRD(h2, b_ + 10240); TRRD(l3, b_ + 12288); TRRD(h3, b_ + 14336); \
        asm volatile("s_waitcnt lgkmcnt(0)" ::: "memory"); SBAR();   \
        o[d0] = __builtin_amdgcn_mfma_f32_32x32x16_bf16(pa0, (bf16x8){l0[0], l0[1], l0[2], l0[3], h0[0], h0[1], h0[2], h0[3]}, o[d0], 0, 0, 0);   \
        o[d0] = __builtin_amdgcn_mfma_f32_32x32x16_bf16(pa1, (bf16x8){l1[0], l1[1], l1[2], l1[3], h1[0], h1[1], h1[2], h1[3]}, o[d0], 0, 0, 0);   \
        o[d0] = __builtin_amdgcn_mfma_f32_32x32x16_bf16(pa2, (bf16x8){l2[0], l2[1], l2[2], l2[3], h2[0], h2[1], h2[2], h2[3]}, o[d0], 0, 0, 0);   \
        o[d0] = __builtin_amdgcn_mfma_f32_32x32x16_bf16(pa3, (bf16x8){l3[0], l3[1], l3[2], l3[3], h3[0], h3[1], h3[2], h3[3]}, o[d0], 0, 0, 0); } while (0)
    PV_D0(0); PV_D0(1); PV_D0(2); PV_D0(3);
#undef PV_D0
#undef TRRD
}
struct BlockRef { const bf16_t* Q; const bf16_t* K; const bf16_t* V; int P0; };
__device__ __forceinline__ void diff_block(const int MODE, const BlockRef& cur, float slope2, float lam, f32x4* stash, bf16_t* O, char* lds) {
    int tid_ = threadIdx.x; asm volatile("" : "+v"(tid_));
    const int tid = tid_, wid = __builtin_amdgcn_readfirstlane(tid >> 6), lane = tid & 63, r32 = lane & 31, hi = lane >> 5;
    const int NT = (cur.P0 + QB) / KVBLK;
    const int qlo = cur.P0 + wid * QBLK, qm = qlo + r32 - 4 * hi;
    char* V_lds = lds; char* K_lds = lds + 2 * SHM_V;
    float* wsf = (float*)(lds + 2 * SHM_V + 2 * SHM_K) + wid * 64; float* li_l = wsf, * al_l = wsf + 32;
    float m_reg = -1e30f, l_reg = 0; f32x16 o[4] = {};
    const int sr = tid >> 4, sc = (tid & 15) * 8, vst0 = v_st(sr, sc), vst1 = v_st(32 + sr, sc);
    const int kr = tid >> 3, kc = (tid & 7) * 8, kws = KSWZ(kr, kc * 2);
    const int vb0 = (int)(uintptr_t)V_lds + v_rd_base(lane);
    const bf16_t* Kh = cur.K; const bf16_t* Vh = cur.V;
    bf16x8 st_v0, st_v1, st_k0;
#define KBASE(t) ((NT - 1 - (t)) * KVBLK)
#define SLOAD(t) do { const int k0_ = KBASE(t); st_v0 = *(const bf16x8*)(Vh + (size_t)(k0_ + sr) * PITCH + sc); st_v1 = *(const bf16x8*)(Vh + (size_t)(k0_ + 32 + sr) * PITCH + sc); \
                      st_k0 = *(const bf16x8*)(Kh + (size_t)(k0_ + kr) * PITCH + kc); } while (0)
#define SWRITE_K(bf) do { *(bf16x8*)(K_lds + (bf) * SHM_K + kws) = st_k0; } while (0)
#define SWRITE_V(bf) do { *(bf16x8*)(V_lds + (bf) * SHM_V + vst0) = st_v0; *(bf16x8*)(V_lds + (bf) * SHM_V + vst1) = st_v1; } while (0)
#define VMW() asm volatile("s_waitcnt vmcnt(0)" ::: "memory")
#define RESC(a) do { if (__any((a) < 1.f)) { if (hi == 0) al_l[r32] = (a); asm volatile("s_waitcnt lgkmcnt(0)" ::: "memory");              \
                     _Pragma("unroll") for (int d_ = 0; d_ < 4; ++d_) _Pragma("unroll") for (int r = 0; r < 16; ++r) o[d_][r] *= al_l[crow(r, hi)]; } } while (0)
#define OFF0(t) (slope2 * (float)(KBASE(t) + 4 * hi - (qlo + r32)))
#define MASKT(P0_, P1_, t) do { const int kb_ = KBASE(t); if (kb_ + KVBLK - 1 > qlo) mask_tile(P0_, P1_, qm - kb_); } while (0)
    bf16x8 qr[4];
#pragma unroll
    for (int d0 = 0; d0 < 4; ++d0) qr[d0] = *(const bf16x8*)(cur.Q + (size_t)(wid * QBLK + r32) * PITCH + d0 * 16 + hi * 8);
    SLOAD(0); VMW(); SWRITE_K(0); SWRITE_V(0); SBAR();
    if (NT > 1) SLOAD(1);
    __syncthreads();
    f32x16 pA0, pA1, pB0, pB1; float alA, alB; bf16x8 pa0, pa1, pa2, pa3;
    SBAR(); qkt<0>(pA0, pA1, K_lds, r32, hi, qr, slope2, OFF0(0));
    MASKT(pA0, pA1, 0); partialSM(pA0, pA1, m_reg, alA);
    if (NT > 1) { VMW(); SWRITE_K(1); SWRITE_V(1); }
    __syncthreads();
#define HALF_STEP(PX0, PX1, alX, PY0, PY1, alY, t, KB, VB, SB) do {                                                      \
        SBAR(); qkt<KB>(PX0, PX1, K_lds, r32, hi, qr, slope2, OFF0(t));                                                  \
        finishSM(PY0, PY1, alY, l_reg, pa0, pa1, pa2, pa3); SBAR();                                                      \
        if ((t) + 1 < NT) { SLOAD((t) + 1); SBAR(); }                                                                    \
        pv_tile<VB>(o, vb0, pa0, pa1, pa2, pa3); MASKT(PX0, PX1, (t)); partialSM(PX0, PX1, m_reg, alX);                  \
        __syncthreads();                                                                                                 \
        if ((t) + 1 < NT) { VMW(); SWRITE_K(SB); SWRITE_V(SB); }                                                         \
        RESC(alX); __syncthreads(); } while (0)
    for (int t = 1; t + 1 < NT; t += 2) {
        HALF_STEP(pB0, pB1, alB, pA0, pA1, alA, t, 1, 0, 0);
        HALF_STEP(pA0, pA1, alA, pB0, pB1, alB, t + 1, 0, 1, 1);
    }
    SBAR(); qkt<1>(pB0, pB1, K_lds, r32, hi, qr, slope2, OFF0(NT - 1)); SBAR();
    finishSM(pA0, pA1, alA, l_reg, pa0, pa1, pa2, pa3); SBAR();
    pv_tile<0>(o, vb0, pa0, pa1, pa2, pa3);
    MASKT(pB0, pB1, NT - 1); partialSM(pB0, pB1, m_reg, alB); RESC(alB);
    finishSM(pB0, pB1, alB, l_reg, pa0, pa1, pa2, pa3); SBAR(); pv_tile<1>(o, vb0, pa0, pa1, pa2, pa3);
    if (hi == 0) li_l[r32] = l_reg; asm volatile("s_waitcnt lgkmcnt(0)" ::: "memory");
    float rli[16];
#pragma unroll
    for (int r = 0; r < 16; ++r) rli[r] = __builtin_amdgcn_rcpf(li_l[crow(r, hi)]);
    if (MODE == 0) {
#pragma unroll
        for (int d0 = 0; d0 < 4; ++d0)
#pragma unroll
            for (int g = 0; g < 4; ++g) { f32x4 v; v[0] = o[d0][4 * g] * rli[4 * g]; v[1] = o[d0][4 * g + 1] * rli[4 * g + 1]; v[2] = o[d0][4 * g + 2] * rli[4 * g + 2]; v[3] = o[d0][4 * g + 3] * rli[4 * g + 3];
                stash[(size_t)(d0 * 4 + g) * 512 + tid] = v; }
    } else {
        float ss[16];
#pragma unroll
        for (int r = 0; r < 16; ++r) ss[r] = 0.f;
#pragma unroll
        for (int d0 = 0; d0 < 4; ++d0)
#pragma unroll
            for (int g = 0; g < 4; ++g) { const f32x4 s1 = stash[(size_t)(d0 * 4 + g) * 512 + tid];
#pragma unroll
                for (int j = 0; j < 4; ++j) { const int r = 4 * g + j; const float a = s1[j] - lam * (o[d0][r] * rli[r]); o[d0][r] = a; ss[r] += a * a; } }
#pragma unroll
        for (int r = 0; r < 16; ++r) {
#pragma unroll
            for (int x = 1; x < 32; x <<= 1) ss[r] += __shfl_xor(ss[r], x);
            ss[r] = 1.0f / sqrtf(ss[r] * (1.0f / 128.0f) + EPS); }
        bf16_t* Ow = O + (size_t)(wid * QBLK) * PITCH;
#pragma unroll
        for (int r = 0; r < 16; ++r) { const int orow = crow(r, hi);
#pragma unroll
            for (int d0 = 0; d0 < 4; ++d0) { const float v = o[d0][r] * ss[r]; const float vn = __shfl_xor(v, 1);
                if ((r32 & 1) == 0) *(unsigned*)(Ow + (size_t)orow * PITCH + d0 * 32 + r32) = cvtpk(v, vn); } }
    }
    __syncthreads();
#undef KBASE
#undef SLOAD
#undef SWRITE_K
#undef SWRITE_V
#undef VMW
#undef RESC
#undef OFF0
#undef MASKT
#undef HALF_STEP
}
#undef KSWZ
#undef SBAR
}

struct SrcIn {
    const float* w; const float* g; const float* pw;
    __device__ __forceinline__ float operator()(int k, int n) const {
        const float gk = g[k]; const float* row = w + (size_t)k * INC;
        if (n >= 3072 && n < 3584) { const int grp = (n - 3072) >> 7, d = (n - 3072) & 127; const float* wr = row + 3072 + grp * 128; const float* p = pw + (size_t)grp * 128 * 128 + d;
            float s = 0.f;
            for (int c = 0; c < 128; ++c) s += wr[c] * p[(size_t)c * 128];
            return s * gk; }
        float v = row[n] * gk;
        if (n < 1024) v *= C2Q; else if (n >= 3584 && n < 4096) v *= C2M;
        return v;
    }
};
struct SrcAtt { const float* w; const float* g; __device__ __forceinline__ float operator()(int k, int n) const { return w[(size_t)k * DM + n] * g[k & 127] * (1.0f - LAM_INIT); } };
struct SrcPool { const float* w; const float* g; __device__ __forceinline__ float operator()(int k, int n) const { return w[(size_t)k * DM + n] * g[k]; } };
struct SrcPlain { const float* w; int N; __device__ __forceinline__ float operator()(int k, int n) const { return w[(size_t)k * N + n]; } };
struct SrcGainK { const float* w; const float* g; int N; __device__ __forceinline__ float operator()(int k, int n) const { return w[(size_t)k * N + n] * g[k]; } };
struct SrcUp {
    const float* w; const float* g;
    __device__ __forceinline__ float operator()(int k, int n) const { const int j = n >> 8, s = (n >> 7) & 1, cc = n & 127; return w[(size_t)k * DFF2 + s * DFF + 128 * j + cc] * g[k]; }
};
template <class F>
__device__ __forceinline__ void transpose_item(const F& src, int K, int N, bf16_t* WT, int ldt, int koff, LAS float* scr, int item, int lane) {
    const int nblk = N / 32, kb = item / nblk, nb = item % nblk, k0 = 64 * kb, n0 = 32 * nb;
    for (int i = 0; i < 32; ++i) { const int kk = 2 * i + (lane >> 5); scr[kk * 33 + (lane & 31)] = src(k0 + kk, n0 + (lane & 31)); }
    asm volatile("s_waitcnt lgkmcnt(0)" ::: "memory");
    const int c = lane & 7;
#pragma unroll
    for (int j = 0; j < 4; ++j) { const int n = (lane >> 3) + 8 * j; const LAS float* s = scr + (8 * c) * 33 + n;
        u32x4 o; o.x = pk2(s[0 * 33], s[1 * 33]); o.y = pk2(s[2 * 33], s[3 * 33]); o.z = pk2(s[4 * 33], s[5 * 33]); o.w = pk2(s[6 * 33], s[7 * 33]);
        *(u32x4*)(WT + (size_t)(n0 + n) * ldt + koff + k0 + 8 * c) = o; }
    asm volatile("s_waitcnt lgkmcnt(0)" ::: "memory");
}
__device__ __forceinline__ void rms_row_to_bf16(const float* xrow, bf16_t* orow, int lane) {
    const f32x4* xr = (const f32x4*)xrow + lane; f32x4 v[4]; float s = 0.f;
#pragma unroll
    for (int j = 0; j < 4; ++j) { v[j] = xr[64 * j]; s += (v[j].x * v[j].x + v[j].y * v[j].y) + (v[j].z * v[j].z + v[j].w * v[j].w); }
    const float rstd = 1.0f / sqrtf(wave_sum(s) * (1.0f / DM) + EPS);
    u32x2* o8 = (u32x2*)orow + lane;
#pragma unroll
    for (int j = 0; j < 4; ++j) { u32x2 w; w.x = pk2(v[j].x * rstd, v[j].y * rstd); w.y = pk2(v[j].z * rstd, v[j].w * rstd); o8[64 * j] = w; }
}

__device__ __forceinline__ void phase0(const Params& p, LAS unsigned char* lds, int gw, int NGW, int wave, int lane) {
    LAS float* scr = (LAS float*)(lds + wave * 16384);
    unsigned char* ws = p.ws;
    const SrcIn sIn{p.in[3], p.in[2], p.in[10]};
    const SrcAtt sAtt{p.in[9], p.in[8]};
    const SrcPool sPool{p.in[12], p.in[11]};
    const SrcPlain sMemB{p.in[15], DM};
    const SrcGainK sMkv{p.in[14], p.in[13], DM};
    const SrcPlain sOut{p.in[16], DM};
    const SrcUp sUp{p.in[19], p.in[18]};
    const SrcPlain sDn{p.in[22], DM};
    constexpr int I_IN = (DM / 64) * (INC / 32), I_SQ = (DM / 64) * (DM / 32), I_H = (512 / 64) * (DM / 32), I_UP = (DM / 64) * (DFF2 / 32), I_DN = (DFF / 64) * (DM / 32);
    constexpr int NITEMS = I_IN + I_SQ + 2 * I_H + I_SQ + I_SQ + I_UP + I_DN;
    for (int it = gw; it < NITEMS; it += NGW) {
        int r = it;
        if (r < I_IN) { transpose_item(sIn, DM, INC, (bf16_t*)(ws + WS_WIN), DM, 0, scr, r, lane); continue; } r -= I_IN;
        if (r < I_SQ) { transpose_item(sAtt, DM, DM, (bf16_t*)(ws + WS_WATT), DM, 0, scr, r, lane); continue; } r -= I_SQ;
        if (r < I_H) { transpose_item(sPool, 512, DM, (bf16_t*)(ws + WS_WPM), DM, 0, scr, r, lane); continue; } r -= I_H;
        if (r < I_H) { transpose_item(sMemB, 512, DM, (bf16_t*)(ws + WS_WPM), DM, 512, scr, r, lane); continue; } r -= I_H;
        if (r < I_SQ) { transpose_item(sMkv, DM, DM, (bf16_t*)(ws + WS_WMKV), DM, 0, scr, r, lane); continue; } r -= I_SQ;
        if (r < I_SQ) { transpose_item(sOut, DM, DM, (bf16_t*)(ws + WS_WOUT), DM, 0, scr, r, lane); continue; } r -= I_SQ;
        if (r < I_UP) { transpose_item(sUp, DM, DFF2, (bf16_t*)(ws + WS_WUP), DM, 0, scr, r, lane); continue; } r -= I_UP;
        transpose_item(sDn, DFF, DM, (bf16_t*)(ws + WS_WDN), DFF, 0, scr, r, lane);
    }
    for (int m = gw; m < TOK; m += NGW) rms_row_to_bf16(p.in[0] + (size_t)m * DM, (bf16_t*)(ws + WS_XN) + (size_t)m * DM, lane);
    for (int m = gw; m < BATCH * MEMTOK; m += NGW) rms_row_to_bf16(p.in[1] + (size_t)m * DM, (bf16_t*)(ws + WS_MEMN) + (size_t)m * DM, lane);
}

__device__ __forceinline__ void phase1(const Params& p, int gw, int NGW, int lane) {
    unsigned char* ws = p.ws;
    const bf16_t* xn = (const bf16_t*)(ws + WS_XN); const bf16_t* win = (const bf16_t*)(ws + WS_WIN);
    bf16_t* qb = (bf16_t*)p.out; bf16_t* kb = qb + (size_t)TOK * DM; bf16_t* vb = (bf16_t*)(ws + WS_V);
    bf16_t* upf = (bf16_t*)(ws + WS_UPF); bf16_t* qm = (bf16_t*)(ws + WS_QM);
    const int fr = lane & 15, fq = lane >> 4;
    constexpr int NT1 = (TOK / 32) * (4096 / 32), NT2 = (512 / 32) * (1024 / 32);
    for (int t = gw; t < NT1 + NT2; t += NGW) {
        f32x4 acc[2][2]; zero_acc(acc);
        if (t < NT1) {
            const int mt = t / 128, nt = t % 128, r0 = mt * 32, c0 = nt * 32;
            wave_gemm<2, 2>(xn, DM, win, DM, DM, r0, c0, acc, lane);
            bf16_t* dst; int ld, cc;
            if (c0 < 1024) { dst = qb; ld = DM; cc = c0; } else if (c0 < 2048) { dst = kb; ld = DM; cc = c0 - 1024; } else if (c0 < 3072) { dst = vb; ld = DM; cc = c0 - 2048; }
            else if (c0 < 3584) { dst = upf; ld = 512; cc = c0 - 3072; } else { dst = qm; ld = 512; cc = c0 - 3584; }
#pragma unroll
            for (int mi = 0; mi < 2; ++mi)
#pragma unroll
                for (int ni = 0; ni < 2; ++ni)
#pragma unroll
                    for (int j = 0; j < 4; ++j) dst[(size_t)(r0 + 16 * mi + 4 * fq + j) * ld + cc + 16 * ni + fr] = (bf16_t)f2bf(acc[mi][ni][j]);
        } else {
            const int tt = t - NT1, mt = tt / 32, nt = tt % 32, r0 = mt * 32, c0 = nt * 32;
            wave_gemm<2, 2>((const bf16_t*)(ws + WS_MEMN), DM, (const bf16_t*)(ws + WS_WMKV), DM, DM, r0, c0, acc, lane);
            bf16_t* dst = (bf16_t*)(ws + WS_KVM);
#pragma unroll
            for (int mi = 0; mi < 2; ++mi)
#pragma unroll
                for (int ni = 0; ni < 2; ++ni)
#pragma unroll
                    for (int j = 0; j < 4; ++j) dst[(size_t)(r0 + 16 * mi + 4 * fq + j) * DM + c0 + 16 * ni + fr] = (bf16_t)f2bf(acc[mi][ni][j]);
        }
    }
}

__device__ __forceinline__ float lam_value(const Params& p) {
    float s1 = 0.f, s2 = 0.f;
    for (int i = 0; i < 64; ++i) { s1 += p.in[4][i] * p.in[5][i]; s2 += p.in[6][i] * p.in[7][i]; }
    return expf(s1) - expf(s2) + LAM_INIT;
}
__device__ __forceinline__ void load16(const bf16_t* p, float* o) {
    const u32x4 a = *(const u32x4*)p, b = *(const u32x4*)(p + 8);
    const unsigned w[8] = {a.x, a.y, a.z, a.w, b.x, b.y, b.z, b.w};
#pragma unroll
    for (int i = 0; i < 8; ++i) { o[2 * i] = __uint_as_float(w[i] << 16); o[2 * i + 1] = __uint_as_float(w[i] & 0xffff0000u); }
}
__device__ __forceinline__ void phase2_diff(const Params& p, int gw, int NGW, int lane) {
    unsigned char* ws = p.ws;
    const bf16_t* Q = (const bf16_t*)p.out; const bf16_t* Kb = Q + (size_t)TOK * DM; const bf16_t* Vb = (const bf16_t*)(ws + WS_V);
    bf16_t* an = (bf16_t*)(ws + WS_AN);
    const float lam = lam_value(p);
    const int sub = lane & 3, qi = lane >> 2;
    for (int r = 0; r * NGW + gw < 8192; ++r) {
        const int ig = r * NGW + gw, h = ig & 7, tq = ig >> 3, b = tq >> 9; int tg = tq & 511; if (tg & 256) tg = 767 - tg;
        const int t = tg * 16 + qi; const size_t gm = (size_t)b * SEQ + t;
        const float slope2 = exp2f(-(float)(h + 1)) * LOG2E;
        float o1[32];
        float oo[32];
#pragma unroll
        for (int c = 0; c < 2; ++c) {
            float qv[16]; load16(Q + gm * DM + h * 128 + c * 64 + sub * 16, qv);
            float m = -1e30f, l = 0.f;
#pragma unroll
            for (int e = 0; e < 32; ++e) oo[e] = 0.f;
            const int tmax = tg * 16 + 15;
            const bf16_t* kp = Kb + (size_t)b * SEQ * DM + h * 128 + c * 64 + sub * 16;
            const bf16_t* vp = Vb + (size_t)b * SEQ * DM + h * 128 + sub * 32;
            for (int j = 0; j <= tmax; ++j) {
                float kv[16]; load16(kp + (size_t)j * DM, kv);
                float s = 0.f;
#pragma unroll
                for (int d = 0; d < 16; ++d) s += qv[d] * kv[d];
                s += __shfl_xor(s, 1); s += __shfl_xor(s, 2);
                s -= slope2 * (float)(t - j);
                const bool valid = j <= t;
                const float mn = valid ? fmaxf(m, s) : m;
                const float alpha = __builtin_amdgcn_exp2f(m - mn);
                const float pr = valid ? __builtin_amdgcn_exp2f(s - mn) : 0.f;
                l = l * alpha + pr; m = mn;
                float vv[32]; load16(vp + (size_t)j * DM, vv); load16(vp + (size_t)j * DM + 16, vv + 16);
#pragma unroll
                for (int e = 0; e < 32; ++e) oo[e] = oo[e] * alpha + pr * vv[e];
            }
            const float il = 1.0f / l;
            if (c == 0) {
#pragma unroll
                for (int e = 0; e < 32; ++e) o1[e] = oo[e] * il;
            } else {
#pragma unroll
                for (int e = 0; e < 32; ++e) oo[e] = o1[e] - lam * (oo[e] * il);
            }
        }
        float ss = 0.f;
#pragma unroll
        for (int e = 0; e < 32; ++e) ss += oo[e] * oo[e];
        ss += __shfl_xor(ss, 1); ss += __shfl_xor(ss, 2);
        const float rstd = 1.0f / sqrtf(ss * (1.0f / 128.0f) + EPS);
        bf16_t* dst = an + gm * DM + h * 128 + sub * 32;
#pragma unroll
        for (int e = 0; e < 32; e += 2) *(unsigned*)(dst + e) = pk2(oo[e] * rstd, oo[e + 1] * rstd);
    }
}
__device__ __forceinline__ void phase2_mem(const Params& p, int gw, int NGW, int lane) {
    unsigned char* ws = p.ws;
    const bf16_t* qm = (const bf16_t*)(ws + WS_QM); const bf16_t* kvm = (const bf16_t*)(ws + WS_KVM); bf16_t* po = (bf16_t*)(ws + WS_PO);
    const int sub = lane & 3, qi = lane >> 2;
    for (int ig = gw; ig < (TOK / 16) * NMEMH; ig += NGW) {
        const int h = ig & 3, tq = ig >> 2; const size_t gm = (size_t)tq * 16 + qi; const int b = (int)(gm / SEQ);
        float qv[32]; load16(qm + gm * 512 + h * 128 + sub * 32, qv); load16(qm + gm * 512 + h * 128 + sub * 32 + 16, qv + 16);
        float m = -1e30f, l = 0.f, oo[32];
#pragma unroll
        for (int e = 0; e < 32; ++e) oo[e] = 0.f;
        const bf16_t* kp = kvm + (size_t)b * MEMTOK * DM + h * 128 + sub * 32;
        for (int j = 0; j < MEMTOK; ++j) {
            float kv[32]; load16(kp + (size_t)j * DM, kv); load16(kp + (size_t)j * DM + 16, kv + 16);
            float s = 0.f;
#pragma unroll
            for (int d = 0; d < 32; ++d) s += qv[d] * kv[d];
            s += __shfl_xor(s, 1); s += __shfl_xor(s, 2);
            const float mn = fmaxf(m, s), alpha = __builtin_amdgcn_exp2f(m - mn), pr = __builtin_amdgcn_exp2f(s - mn);
            l = l * alpha + pr; m = mn;
            float vv[32]; load16(kp + (size_t)j * DM + 512, vv); load16(kp + (size_t)j * DM + 512 + 16, vv + 16);
#pragma unroll
            for (int e = 0; e < 32; ++e) oo[e] = oo[e] * alpha + pr * vv[e];
        }
        const float il = 1.0f / l;
        bf16_t* dst = po + gm * DM + 512 + h * 128 + sub * 32;
#pragma unroll
        for (int e = 0; e < 32; e += 2) *(unsigned*)(dst + e) = pk2(oo[e] * il, oo[e + 1] * il);
    }
}
__device__ __forceinline__ void phase2_pool(const Params& p, int gtid, int NGT) {
    unsigned char* ws = p.ws;
    const bf16_t* upf = (const bf16_t*)(ws + WS_UPF); bf16_t* po = (bf16_t*)(ws + WS_PO);
    for (size_t i = gtid; i < (size_t)TOK * 512; i += NGT) {
        const int c = (int)(i & 511); const size_t gm = i >> 9; const int t = (int)(gm & (SEQ - 1)); const int w = 2 << (c >> 7);
        const int lo = t + 1 - w > 0 ? t + 1 - w : 0; const int cnt = t + 1 < w ? t + 1 : w;
        float s = 0.f;
        for (int j = lo; j <= t; ++j) s += bf2f(upf[(gm - t + j) * 512 + c]);
        po[gm * DM + c] = (bf16_t)f2bf(s / (float)cnt - bf2f(upf[gm * 512 + c]));
    }
}

__device__ __forceinline__ void phase3(const Params& p, int gw, int NGW, int lane) {
    unsigned char* ws = p.ws;
    const bf16_t* xn = (const bf16_t*)(ws + WS_XN); const bf16_t* win = (const bf16_t*)(ws + WS_WIN);
    const bf16_t* an = (const bf16_t*)(ws + WS_AN); const bf16_t* po = (const bf16_t*)(ws + WS_PO);
    const bf16_t* watt = (const bf16_t*)(ws + WS_WATT); const bf16_t* wpm = (const bf16_t*)(ws + WS_WPM);
    bf16_t* mix = (bf16_t*)(ws + WS_MIX);
    const int fr = lane & 15, fq = lane >> 4;
    for (int t = gw; t < (TOK / 32) * (DM / 32); t += NGW) {
        const int mt = t / 32, nt = t % 32, r0 = mt * 32, c0 = nt * 32;
        f32x4 mx[2][2]; zero_acc(mx);
#pragma unroll
        for (int i = 0; i < 3; ++i) {
            f32x4 ag[2][2], ay[2][2]; zero_acc(ag); zero_acc(ay);
            wave_gemm<2, 2>(xn, DM, win + (size_t)(4096 + i * 1024) * DM, DM, DM, r0, c0, ag, lane);
            if (i == 0) wave_gemm<2, 2>(an, DM, watt, DM, DM, r0, c0, ay, lane);
            else if (i == 1) wave_gemm<2, 2>(po, DM, wpm, DM, 512, r0, c0, ay, lane);
            else wave_gemm<2, 2>(po + 512, DM, wpm + 512, DM, 512, r0, c0, ay, lane);
#pragma unroll
            for (int mi = 0; mi < 2; ++mi)
#pragma unroll
                for (int ni = 0; ni < 2; ++ni)
#pragma unroll
                    for (int j = 0; j < 4; ++j) mx[mi][ni][j] += sigmoidf_(ag[mi][ni][j]) * ay[mi][ni][j];
        }
#pragma unroll
        for (int mi = 0; mi < 2; ++mi)
#pragma unroll
            for (int ni = 0; ni < 2; ++ni)
#pragma unroll
                for (int j = 0; j < 4; ++j) mix[(size_t)(r0 + 16 * mi + 4 * fq + j) * DM + c0 + 16 * ni + fr] = (bf16_t)f2bf(mx[mi][ni][j]);
    }
}

__device__ __forceinline__ void gemm_f32out(const bf16_t* A, int lda, const bf16_t* Bt, int ldb, int K, int M, int N, float* C, int gw, int NGW, int lane) {
    const int fr = lane & 15, fq = lane >> 4; const int ntn = N / 32;
    for (int t = gw; t < (M / 32) * ntn; t += NGW) {
        const int mt = t / ntn, nt = t % ntn, r0 = mt * 32, c0 = nt * 32;
        f32x4 acc[2][2]; zero_acc(acc);
        wave_gemm<2, 2>(A, lda, Bt, ldb, K, r0, c0, acc, lane);
#pragma unroll
        for (int mi = 0; mi < 2; ++mi)
#pragma unroll
            for (int ni = 0; ni < 2; ++ni)
#pragma unroll
                for (int j = 0; j < 4; ++j) C[(size_t)(r0 + 16 * mi + 4 * fq + j) * N + c0 + 16 * ni + fr] = acc[mi][ni][j];
    }
}
__device__ __forceinline__ void norm_res_rows(const float* z, const float* base, const float* g, float* out, bf16_t* xn2, int gw, int NGW, int lane) {
    for (int m = gw; m < TOK; m += NGW) {
        const f32x4* zr = (const f32x4*)(z + (size_t)m * DM) + lane; const f32x4* br = (const f32x4*)(base + (size_t)m * DM) + lane; const f32x4* gr = (const f32x4*)g + lane;
        f32x4 v[4]; float s = 0.f;
#pragma unroll
        for (int j = 0; j < 4; ++j) { v[j] = zr[64 * j]; s += (v[j].x * v[j].x + v[j].y * v[j].y) + (v[j].z * v[j].z + v[j].w * v[j].w); }
        const float rstd = 1.0f / sqrtf(wave_sum(s) * (1.0f / DM) + EPS);
        float s2 = 0.f;
#pragma unroll
        for (int j = 0; j < 4; ++j) { v[j] = br[64 * j] + v[j] * rstd * gr[64 * j]; s2 += (v[j].x * v[j].x + v[j].y * v[j].y) + (v[j].z * v[j].z + v[j].w * v[j].w); }
        f32x4* orow = (f32x4*)(out + (size_t)m * DM) + lane;
#pragma unroll
        for (int j = 0; j < 4; ++j) orow[64 * j] = v[j];
        if (xn2) {
            const float r2 = 1.0f / sqrtf(wave_sum(s2) * (1.0f / DM) + EPS);
            u32x2* o8 = (u32x2*)(xn2 + (size_t)m * DM) + lane;
#pragma unroll
            for (int j = 0; j < 4; ++j) { u32x2 w; w.x = pk2(v[j].x * r2, v[j].y * r2); w.y = pk2(v[j].z * r2, v[j].w * r2); o8[64 * j] = w; }
        }
    }
}

__device__ __forceinline__ void phase5(const Params& p, LAS unsigned char* lds, int gw, int NGW, int wave, int lane) {
    unsigned char* ws = p.ws;
    const bf16_t* xn2 = (const bf16_t*)(ws + WS_XN2); const bf16_t* wup = (const bf16_t*)(ws + WS_WUP); bf16_t* ff = (bf16_t*)(ws + WS_FF);
    const float* cw = p.in[20]; const float* cb = p.in[21];
    LAS float* scr = (LAS float*)(lds + wave * 16384);
    const int fr = lane & 15, fq = lane >> 4;
    for (int t = gw; t < (TOK / 32) * (DFF / 32); t += NGW) {
        const int mt = t / 88, ct = t % 88, m0 = mt * 32, ch0 = ct * 32;
        const int grow = 256 * (ch0 >> 7) + (ch0 & 127);
        f32x4 ag[3][2], av[3][2]; zero_acc(ag); zero_acc(av);
        wave_gemm<3, 2>(xn2, DM, wup, DM, DM, m0 - 16, grow, ag, lane);
        wave_gemm<3, 2>(xn2, DM, wup, DM, DM, m0 - 16, grow + 128, av, lane);
#pragma unroll
        for (int mi = 0; mi < 3; ++mi)
#pragma unroll
            for (int ni = 0; ni < 2; ++ni)
#pragma unroll
                for (int j = 0; j < 4; ++j) { const int rr = 16 * mi + 4 * fq + j; scr[rr * 64 + 16 * ni + fr] = ag[mi][ni][j]; scr[rr * 64 + 32 + 16 * ni + fr] = av[mi][ni][j]; }
        asm volatile("s_waitcnt lgkmcnt(0)" ::: "memory");
        const int c = lane & 31, ch = ch0 + c;
        const float wg0 = cw[ch], wg1 = cw[DFF2 + ch], wg2 = cw[2 * DFF2 + ch], bg = cb[ch];
        const float wv0 = cw[DFF + ch], wv1 = cw[DFF2 + DFF + ch], wv2 = cw[2 * DFF2 + DFF + ch], bv = cb[DFF + ch];
        for (int i = 0; i < 16; ++i) {
            const int r = (lane >> 5) + 2 * i, m = m0 + r, tt = m & (SEQ - 1);
            const float g2 = scr[(16 + r) * 64 + c], g1 = tt >= 1 ? scr[(15 + r) * 64 + c] : 0.f, g0 = tt >= 2 ? scr[(14 + r) * 64 + c] : 0.f;
            const float v2 = scr[(16 + r) * 64 + 32 + c], v1 = tt >= 1 ? scr[(15 + r) * 64 + 32 + c] : 0.f, v0 = tt >= 2 ? scr[(14 + r) * 64 + 32 + c] : 0.f;
            const float cgv = bg + wg0 * g0 + wg1 * g1 + wg2 * g2, cvv = bv + wv0 * v0 + wv1 * v1 + wv2 * v2;
            ff[(size_t)m * DFF + ch] = (bf16_t)f2bf(gelu_tanh(cgv) * cvv);
        }
        asm volatile("s_waitcnt lgkmcnt(0)" ::: "memory");
    }
}

__global__ void __launch_bounds__(NTHREADS, 2) mega_fwd(Params p) {
    extern __shared__ __attribute__((aligned(16))) unsigned char lds_raw[];
    LAS unsigned char* lds = (LAS unsigned char*)lds_raw;
    cg::grid_group grid = cg::this_grid();
    const int tid = threadIdx.x, lane = tid & 63, wave = tid >> 6;
    const int G = gridDim.x, gw = blockIdx.x * NWAVES + wave, NGW = G * NWAVES;
    unsigned char* ws = p.ws;

    phase0(p, lds, gw, NGW, wave, lane);
    grid.sync();
    {
        pg8::SchedStd S; S.init(TOK, 4096, G, (int)blockIdx.x); S.A = (const bf16_t*)(ws + WS_XN); S.Bt = (const bf16_t*)(ws + WS_WIN); S.K = DM;
        bf16_t* qb = (bf16_t*)p.out;
        pg8::EpiP1 E{qb, qb + (size_t)TOK * DM, (bf16_t*)(ws + WS_V), (bf16_t*)(ws + WS_UPF), (bf16_t*)(ws + WS_QM)};
        pg8::gemm_phase<pg8::EpiP1, pg8::SchedStd, true>(lds, DM, S, E);
        pg8::SchedStd S2; S2.init(BATCH * MEMTOK, DM, G, (int)blockIdx.x); S2.A = (const bf16_t*)(ws + WS_MEMN); S2.Bt = (const bf16_t*)(ws + WS_WMKV); S2.K = DM;
        pg8::EpiBf16Plain E2{(bf16_t*)(ws + WS_KVM), DM};
        pg8::gemm_phase<pg8::EpiBf16Plain, pg8::SchedStd, true>(lds, DM, S2, E2);
    }
    grid.sync();
    {
        const float lam = lam_value(p);
        const bf16_t* Qb = (const bf16_t*)p.out; const bf16_t* Kb = Qb + (size_t)TOK * DM; const bf16_t* Vb = (const bf16_t*)(ws + WS_V);
        bf16_t* an = (bf16_t*)(ws + WS_AN); f32x4* stash = (f32x4*)(ws + WS_MIX) + (size_t)blockIdx.x * 16 * 512;
        const int vcu = (G % 8 == 0) ? (int)(blockIdx.x % 8) * (G / 8) + (int)blockIdx.x / 8 : (int)blockIdx.x;
        for (int pi = vcu; pi < 256; pi += G) {
            const int bh = pi >> 4, s = pi & 15, b = bh >> 3, h = bh & 7;
            const float slope2 = exp2f(-(float)(h + 1)) * LOG2E;
            for (int it = 0; it < 4; ++it) {
                const int qb = (it >> 1) ? 31 - s : s, c = it & 1; const size_t row0 = (size_t)b * SEQ + (size_t)qb * 256;
                dat::BlockRef r{Qb + row0 * DM + h * 128 + c * 64, Kb + (size_t)b * SEQ * DM + h * 128 + c * 64, Vb + (size_t)b * SEQ * DM + h * 128, qb * 256};
                dat::diff_block(c, r, slope2, lam, stash, an + row0 * DM + h * 128, (char*)lds_raw);
            }
        }
    }
    phase2_mem(p, gw, NGW, lane);
    phase2_pool(p, blockIdx.x * NTHREADS + tid, G * NTHREADS);
    grid.sync();
    phase3(p, gw, NGW, lane);
    grid.sync();
    {
        pg8::SchedStd S; S.init(TOK, DM, G, (int)blockIdx.x); S.A = (const bf16_t*)(ws + WS_MIX); S.Bt = (const bf16_t*)(ws + WS_WOUT); S.K = DM;
        pg8::EpiF32 E{(float*)(ws + WS_Z), DM};
        pg8::gemm_phase<pg8::EpiF32, pg8::SchedStd, false>(lds, DM, S, E);
    }
    grid.sync();
    norm_res_rows((const float*)(ws + WS_Z), p.in[0], p.in[17], p.out, (bf16_t*)(ws + WS_XN2), gw, NGW, lane);
    grid.sync();
    phase5(p, lds, gw, NGW, wave, lane);
    grid.sync();
    {
        pg8::SchedStd S; S.init(TOK, DM, G, (int)blockIdx.x); S.A = (const bf16_t*)(ws + WS_FF); S.Bt = (const bf16_t*)(ws + WS_WDN); S.K = DFF;
        pg8::EpiF32 E{(float*)(ws + WS_Z), DM};
        pg8::gemm_phase<pg8::EpiF32, pg8::SchedStd, false>(lds, DFF, S, E);
    }
    grid.sync();
    norm_res_rows((const float*)(ws + WS_Z), p.out, p.in[23], p.out, nullptr, gw, NGW, lane);
}

extern "C" void kernel_launch(void* const* d_in, const int* in_sizes, int n_in, void* d_out, int out_size, void* d_ws, size_t ws_size, hipStream_t stream) {
    static int grid = 0;
    if (grid == 0) {
        if (n_in != 24 || out_size != TOK * DM || ws_size < WS_END) { fprintf(stderr, "kernel_launch: unexpected shapes (n_in %d out %d ws %zu)\n", n_in, out_size, ws_size); grid = -1; return; }
        int dev = 0, cus = 0, per_cu = 0;
        (void)hipGetDevice(&dev); (void)hipDeviceGetAttribute(&cus, hipDeviceAttributeMultiprocessorCount, dev);
        (void)hipFuncSetAttribute((const void*)mega_fwd, hipFuncAttributeMaxDynamicSharedMemorySize, LDS_BYTES);
        if (hipOccupancyMaxActiveBlocksPerMultiprocessor(&per_cu, (const void*)mega_fwd, NTHREADS, LDS_BYTES) != hipSuccess || per_cu < 1) per_cu = 1;
        grid = cus * per_cu;
        if (grid <= 0) grid = 256;
    }
    if (grid < 0) return;
    Params p{};
    for (int i = 0; i < 24; ++i) p.in[i] = (const float*)d_in[i];
    p.out = (float*)d_out; p.ws = (unsigned char*)d_ws;
    void* args[] = {&p};
    hipError_t e = hipLaunchCooperativeKernel((const void*)mega_fwd, dim3(grid), dim3(NTHREADS), args, LDS_BYTES, stream);
    if (e != hipSuccess) fprintf(stderr, "cooperative launch failed: %s (grid %d)\n", hipGetErrorString(e), grid);
}
```

```cpp
#include <hip/hip_runtime.h>
#include <hip/hip_cooperative_groups.h>
#include <cstdio>
#include <cstdint>
namespace cg = cooperative_groups;

#define LAS __attribute__((address_space(3)))
typedef unsigned short bf16_t;
typedef short bf16x8 __attribute__((ext_vector_type(8)));
typedef float f32x4 __attribute__((ext_vector_type(4)));
typedef unsigned u32x4 __attribute__((ext_vector_type(4)));
typedef unsigned u32x2 __attribute__((ext_vector_type(2)));

constexpr int BATCH = 2, SEQ = 8192, DM = 1024, TOK = BATCH * SEQ;
constexpr int MEMTOK = 256, NMEMH = 4, DHM = 128, MEMW = 512;
constexpr int NH = 8, DHD = 64, DV = 128;
constexpr int POOLW = 512;
constexpr int INC = 7168, DFF = 2816, DFF2 = 5632;
constexpr float EPS = 1e-6f;
constexpr float LOG2E = 1.4426950408889634f;
constexpr float C2Q = 0.125f * LOG2E;
constexpr float C2M = 0.08838834764831845f * LOG2E;
constexpr float LAM_INIT = 0.2f;

constexpr size_t MiB = 1u << 20;
constexpr size_t WS_CTL = 0;
constexpr size_t WS_WIN = 1 * MiB;
constexpr size_t WS_WATT = 15 * MiB;
constexpr size_t WS_WPM = 17 * MiB;
constexpr size_t WS_WMKV = 19 * MiB;
constexpr size_t WS_WOUT = 21 * MiB;
constexpr size_t WS_WUP = 23 * MiB;
constexpr size_t WS_WDN = 34 * MiB;
constexpr size_t WS_MEMN = 40 * MiB;
constexpr size_t WS_KVM = 41 * MiB;
constexpr size_t WS_XN = 42 * MiB;
constexpr size_t WS_V = 74 * MiB;
constexpr size_t WS_UPF = 106 * MiB;
constexpr size_t WS_QM = 122 * MiB;
constexpr size_t WS_AN = 138 * MiB;
constexpr size_t WS_PO = 170 * MiB;
constexpr size_t WS_MIX = 202 * MiB;
constexpr size_t WS_GP = 74 * MiB;
constexpr size_t WS_Z = 42 * MiB;
constexpr size_t WS_XN2 = 106 * MiB;
constexpr size_t WS_FF = 138 * MiB;
constexpr size_t WS_END = 234 * MiB;
constexpr int LDS_BYTES = 147456;
constexpr int NTHREADS = 512, NWAVES = 8;

struct Params { const float* in[24]; float* out; unsigned char* ws; };

__device__ __forceinline__ float bf2f(bf16_t v) { return __uint_as_float((unsigned)v << 16); }
__device__ __forceinline__ unsigned f2bf(float f) { unsigned u = __float_as_uint(f); return (u + 0x7fffu + ((u >> 16) & 1u)) >> 16; }
__device__ __forceinline__ unsigned pk2(float lo, float hi) { return f2bf(lo) | (f2bf(hi) << 16); }
__device__ __forceinline__ float wave_sum(float v) {
#pragma unroll
    for (int o = 1; o < 64; o <<= 1) v += __shfl_xor(v, o);
    return v;
}
__device__ __forceinline__ float sigmoidf_(float z) { return 1.0f / (1.0f + __builtin_amdgcn_exp2f(-z * LOG2E)); }
__device__ __forceinline__ float gelu_tanh(float x) {
    const float y = 0.7978845608028654f * (x + 0.044715f * x * x * x);
    return x / (1.0f + __builtin_amdgcn_exp2f(-2.0f * LOG2E * y));
}

template <int MI, int NI>
__device__ __forceinline__ void wave_gemm(const bf16_t* __restrict__ A, int lda, const bf16_t* __restrict__ Bt, int ldb, int K,
                                          int r0, int c0, f32x4 (&acc)[MI][NI], int lane) {
    const int fr = lane & 15, fq = lane >> 4;
    const bf16_t* ap[MI]; const bf16_t* bp[NI];
#pragma unroll
    for (int mi = 0; mi < MI; ++mi) { int r = r0 + 16 * mi + fr; if (r < 0) r = 0; ap[mi] = A + (size_t)r * lda + 8 * fq; }
#pragma unroll
    for (int ni = 0; ni < NI; ++ni) bp[ni] = Bt + (size_t)(c0 + 16 * ni + fr) * ldb + 8 * fq;
#pragma unroll 2
    for (int k0 = 0; k0 < K; k0 += 32) {
        bf16x8 a[MI], b[NI];
#pragma unroll
        for (int mi = 0; mi < MI; ++mi) a[mi] = *(const bf16x8*)(ap[mi] + k0);
#pragma unroll
        for (int ni = 0; ni < NI; ++ni) b[ni] = *(const bf16x8*)(bp[ni] + k0);
#pragma unroll
        for (int mi = 0; mi < MI; ++mi)
#pragma unroll
            for (int ni = 0; ni < NI; ++ni) acc[mi][ni] = __builtin_amdgcn_mfma_f32_16x16x32_bf16(a[mi], b[ni], acc[mi][ni], 0, 0, 0);
    }
}
template <int MI, int NI> __device__ __forceinline__ void zero_acc(f32x4 (&acc)[MI][NI]) {
#pragma unroll
    for (int mi = 0; mi < MI; ++mi)
#pragma unroll
        for (int ni = 0; ni < NI; ++ni) acc[mi][ni] = (f32x4){0.f, 0.f, 0.f, 0.f};
}


namespace pg8 {
#define PG8_LAS __attribute__((address_space(3)))
constexpr int BM = 256, BK = 64, HALF = 128, HTB = HALF * BK * 2  , STAGE_BYTES = 8 * HTB, NXCD = 8, WGM = 8;
__host__ __device__ __forceinline__ int lds_byte(int r, int c) { const int st = (r >> 4) * 2 + (c >> 5), rr = r & 15, cc = c & 31, ob = rr * 64 + cc * 2; return st * 1024 + (ob ^ (((ob >> 9) & 1) << 5)); }
__host__ __device__ __forceinline__ void stage_rc(int b, int& R, int& C) { const int st = b / 1024, sb = b % 1024, swz = sb ^ (((sb >> 9) & 1) << 5); R = (st >> 1) * 16 + swz / 64; C = (st & 1) * 32 + (swz % 64) / 2; }
__host__ __device__ __forceinline__ int perm32(int rho) { const int n = rho >> 4, i = rho & 15; return 8 * (i >> 2) + 4 * n + (i & 3); }
__device__ __forceinline__ unsigned cvt_pk_bf16(float lo, float hi) { unsigned r; asm volatile("v_cvt_pk_bf16_f32 %0, %1, %2" : "=v"(r) : "v"(lo), "v"(hi)); return r; }

struct Unit { int pm, pn, kind; };
struct Ops { const char* a; const char* b; int nt; };

struct StaticOrder {
    int nM, nN, nwg, G, c;
    __host__ __device__ void init(int M, int N, int G_, int c_) { nM = M / BM; nN = N / BM; nwg = nM * nN; G = G_; c = c_; }
    __host__ __device__ bool next(int i, Unit& u) const {
        const long L = (long)i * G + c; if (L >= nwg) return false;
        int wgid = (int)L; { const int q = nwg / NXCD, r = nwg % NXCD, xcd = wgid % NXCD, off = wgid / NXCD; wgid = (xcd < r ? xcd * (q + 1) : r * (q + 1) + (xcd - r) * q) + off; }
        const int nig = WGM * nN, gid = wgid / nig, fm = gid * WGM, gsz = (nM - fm) < WGM ? (nM - fm) : WGM;
        u.pm = fm + ((wgid % nig) % gsz); u.pn = (wgid % nig) / gsz; u.kind = 0; return true;
    }
};
struct SchedStd : StaticOrder {
    const bf16_t* A; const bf16_t* Bt; int K;
    __device__ __forceinline__ Ops ops(const Unit& u) const { Ops o; o.a = (const char*)(A + (size_t)u.pm * BM * K); o.b = (const char*)(Bt + (size_t)u.pn * BM * K); o.nt = K / BK; return o; }
};

struct EpiF32 {
    static constexpr bool PERM = false;
    float* C; int ldc;
    __device__ __forceinline__ void operator()(const f32x4 (&acc)[2][2][4][2], const Unit& u, int wr, int wc, int fr, int fq) const {
        const int row0 = u.pm * BM + wr * 64 + fr, col0 = u.pn * BM + wc * 32 + 4 * fq;
#pragma unroll
        for (int ai = 0; ai < 2; ++ai)
#pragma unroll
            for (int m = 0; m < 4; ++m) { float* rowp = C + (size_t)(row0 + ai * HALF + m * 16) * ldc + col0;
#pragma unroll
                for (int bj = 0; bj < 2; ++bj)
#pragma unroll
                    for (int n = 0; n < 2; ++n) *(f32x4*)(rowp + bj * HALF + n * 16) = acc[ai][bj][m][n]; }
    }
};
__device__ __forceinline__ void store_tile_bf16(const f32x4 (&acc)[2][2][4][2], bf16_t* base, int ldc, int row0, int col0) {
#pragma unroll
    for (int ai = 0; ai < 2; ++ai)
#pragma unroll
        for (int m = 0; m < 4; ++m) { bf16_t* rowp = base + (size_t)(row0 + ai * HALF + m * 16) * ldc + col0;
#pragma unroll
            for (int bj = 0; bj < 2; ++bj) { const f32x4 v0 = acc[ai][bj][m][0], v1 = acc[ai][bj][m][1];
                u32x4 w; w.x = cvt_pk_bf16(v0[0], v0[1]); w.y = cvt_pk_bf16(v0[2], v0[3]); w.z = cvt_pk_bf16(v1[0], v1[1]); w.w = cvt_pk_bf16(v1[2], v1[3]);
                *(u32x4*)(rowp + bj * HALF) = w; } }
}
struct EpiBf16Plain {
    static constexpr bool PERM = true;
    bf16_t* O; int ldc;
    __device__ __forceinline__ void operator()(const f32x4 (&acc)[2][2][4][2], const Unit& u, int wr, int wc, int fr, int fq) const {
        store_tile_bf16(acc, O, ldc, u.pm * BM + wr * 64 + fr, u.pn * BM + wc * 32 + 8 * fq);
    }
};
struct EpiP1 {
    static constexpr bool PERM = true;
    bf16_t* q; bf16_t* k; bf16_t* v; bf16_t* upf; bf16_t* qm;
    __device__ __forceinline__ void operator()(const f32x4 (&acc)[2][2][4][2], const Unit& u, int wr, int wc, int fr, int fq) const {
        const int pn = u.pn; bf16_t* base; int ldc, colt;
        if (pn < 4) { base = q; ldc = 1024; colt = pn * 256; } else if (pn < 8) { base = k; ldc = 1024; colt = (pn - 4) * 256; } else if (pn < 12) { base = v; ldc = 1024; colt = (pn - 8) * 256; }
        else if (pn < 14) { base = upf; ldc = 512; colt = (pn - 12) * 256; } else { base = qm; ldc = 512; colt = (pn - 14) * 256; }
        store_tile_bf16(acc, base, ldc, u.pm * BM + wr * 64 + fr, colt + wc * 32 + 8 * fq);
    }
};


struct SchedGate : StaticOrder {
    const bf16_t *xn, *wg, *an, *watt, *po, *wpm;
    __device__ __forceinline__ bool next(int i, Unit& u) const { const int rnd = i / 6, k = i - rnd * 6; if (!StaticOrder::next(rnd, u)) return false; u.kind = k; return true; }
    __device__ __forceinline__ Ops ops(const Unit& u) const {
        Ops o; const size_t ra = (size_t)u.pm * BM * 1024, rb = (size_t)u.pn * BM * 1024; const int k = u.kind;
        if ((k & 1) == 0) { o.a = (const char*)(xn + ra); o.b = (const char*)(wg + (size_t)(k >> 1) * 1024 * 1024 + rb); o.nt = 16; }
        else if (k == 1) { o.a = (const char*)(an + ra); o.b = (const char*)(watt + rb); o.nt = 16; }
        else if (k == 3) { o.a = (const char*)(po + ra); o.b = (const char*)(wpm + rb); o.nt = 8; }
        else { o.a = (const char*)(po + ra + 512); o.b = (const char*)(wpm + rb + 512); o.nt = 8; }
        return o;
    }
};
struct EpiGate {
    static constexpr bool PERM = true;
    f32x4* gs; f32x4* ps; bf16_t* mix;
    __device__ __forceinline__ void operator()(const f32x4 (&acc)[2][2][4][2], const Unit& u, int wr, int wc, int fr, int fq) const {
        const int k = u.kind;
        f32x4* pg = gs + threadIdx.x; f32x4* pp = ps + threadIdx.x;
        if ((k & 1) == 0) {
#pragma unroll
            for (int ai = 0; ai < 2; ++ai)
#pragma unroll
                for (int m = 0; m < 4; ++m) { asm volatile("" : "+v"(pg));
#pragma unroll
                    for (int bj = 0; bj < 2; ++bj)
#pragma unroll
                        for (int n = 0; n < 2; ++n) { const f32x4 a = acc[ai][bj][m][n]; f32x4 g;
#pragma unroll
                            for (int j = 0; j < 4; ++j) g[j] = __builtin_amdgcn_rcpf(1.0f + __builtin_amdgcn_exp2f(-LOG2E * a[j]));
                            pg[(bj * 2 + n) * 512] = g; }
                    pg += 4 * 512; }
        } else if (k < 5) {
#pragma unroll
            for (int ai = 0; ai < 2; ++ai)
#pragma unroll
                for (int m = 0; m < 4; ++m) { asm volatile("" : "+v"(pg), "+v"(pp));
#pragma unroll
                    for (int bj = 0; bj < 2; ++bj)
#pragma unroll
                        for (int n = 0; n < 2; ++n) { const int q = (bj * 2 + n) * 512;
                            f32x4 v = pg[q] * acc[ai][bj][m][n]; if (k == 3) v += pp[q]; pp[q] = v; }
                    pg += 4 * 512; pp += 4 * 512; asm volatile("" ::: "memory"); }
        } else {
            const int row0 = u.pm * BM + wr * 64 + fr, col0 = u.pn * BM + wc * 32 + 8 * fq;
            bf16_t* rowp = mix + (size_t)row0 * 1024 + col0;
#pragma unroll
            for (int ai = 0; ai < 2; ++ai)
#pragma unroll
                for (int m = 0; m < 4; ++m) { asm volatile("" : "+v"(pg), "+v"(pp), "+v"(rowp));
#pragma unroll
                    for (int bj = 0; bj < 2; ++bj) { const int q = (bj * 2) * 512;
                        const f32x4 v0 = pp[q] + pg[q] * acc[ai][bj][m][0], v1 = pp[q + 512] + pg[q + 512] * acc[ai][bj][m][1];
                        u32x4 w; w.x = cvt_pk_bf16(v0[0], v0[1]); w.y = cvt_pk_bf16(v0[2], v0[3]); w.z = cvt_pk_bf16(v1[0], v1[1]); w.w = cvt_pk_bf16(v1[2], v1[3]);
                        *(u32x4*)(rowp + (size_t)(ai * HALF + m * 16) * 1024 + bj * HALF) = w; }
                    pg += 4 * 512; pp += 4 * 512; asm volatile("" ::: "memory"); }
        }
    }
};


struct SchedUp : StaticOrder {
    const bf16_t* xn2; const bf16_t* wup;
    __device__ __forceinline__ void init2(int G_, int c_) { nM = 66; nN = 22; nwg = nM * nN; G = G_; c = c_; }
    __device__ __forceinline__ Ops ops(const Unit& u) const {
        Ops o; const int b = u.pm / 33, i = u.pm - b * 33; const long row = (long)b * SEQ + 254 * i - 2;
        o.a = (const char*)xn2 + row * (long)(DM * 2); o.b = (const char*)(wup + (size_t)u.pn * BM * DM); o.nt = DM / BK; return o;
    }
};
__device__ __forceinline__ float dpp_prev(float xm1, float x, const int n) {
    const int a = __float_as_int(xm1), b = __float_as_int(x);
    if (n == 1) { const int r = __builtin_amdgcn_update_dpp(0, a, 0x121, 0xF, 0xF, false); return __int_as_float(__builtin_amdgcn_update_dpp(r, b, 0x111, 0xF, 0xF, false)); }
    else { const int r = __builtin_amdgcn_update_dpp(0, a, 0x122, 0xF, 0xF, false); return __int_as_float(__builtin_amdgcn_update_dpp(r, b, 0x112, 0xF, 0xF, false)); }
}
struct EpiConv {
    static constexpr bool PERM = true;
    bf16_t* ff; const float* cw; const float* cb; PG8_LAS f32x4* xch;
    __device__ __forceinline__ void operator()(f32x4 (&acc)[2][2][4][2], const Unit& u, int wr, int wc, int fr_, int fq_) const {
        int lane_ = threadIdx.x & 63; asm volatile("" : "+v"(lane_));
        const int fr = lane_ & 15, fq = lane_ >> 4; (void)fr_; (void)fq_;
        const int b = u.pm / 33, i = u.pm - b * 33, t0 = 254 * i - 2;
        if (fr >= 14) {
#pragma unroll
            for (int ai = 0; ai < 2; ++ai) { PG8_LAS f32x4* slot = xch + ((((ai * 2 + wr) * 4 + wc) * 2 + (fr - 14)) * 4 + fq) * 4;
                slot[0] = acc[ai][0][3][0]; slot[1] = acc[ai][0][3][1]; slot[2] = acc[ai][1][3][0]; slot[3] = acc[ai][1][3][1]; }
        }
        asm volatile("s_waitcnt lgkmcnt(0)" ::: "memory"); __builtin_amdgcn_s_barrier(); asm volatile("" ::: "memory");
        const int chl = u.pn * 128 + wc * 32 + 8 * fq;
        typedef __attribute__((address_space(1))) const f32x4 gf4;
        const float* cwl = cw + chl; const float* cbl = cb + chl; bf16_t* ffl = ff + (size_t)b * SEQ * DFF + chl;
        f32x4 W[2][4][2];
#pragma unroll
        for (int bj = 0; bj < 2; ++bj)
#pragma unroll
            for (int n = 0; n < 2; ++n) { const float* wp = cwl + bj * DFF + 4 * n;
                W[bj][0][n] = *(gf4*)(wp); W[bj][1][n] = *(gf4*)(wp + DFF2); W[bj][2][n] = *(gf4*)(wp + 2 * DFF2); W[bj][3][n] = *(gf4*)(cbl + bj * DFF + 4 * n); }
#pragma unroll
        for (int ai = 0; ai < 2; ++ai) {
            const int run = ai * 2 + wr;
            f32x4 h[2][2];
#pragma unroll
            for (int bj = 0; bj < 2; ++bj)
#pragma unroll
                for (int n = 0; n < 2; ++n) h[bj][n] = (f32x4){0.f, 0.f, 0.f, 0.f};
            if (run > 0 && fr >= 14) { const PG8_LAS f32x4* slot = xch + (((((run - 1) * 4) + wc) * 2 + (fr - 14)) * 4 + fq) * 4;
                h[0][0] = slot[0]; h[0][1] = slot[1]; h[1][0] = slot[2]; h[1][1] = slot[3]; }
            const bool first = (i == 0) && (run == 0);
#pragma unroll
            for (int m = 0; m < 4; ++m) {
                const int r = 128 * ai + 64 * wr + 16 * m + fr, t = t0 + r;
                float y[2][8];
#pragma unroll
                for (int bj = 0; bj < 2; ++bj)
#pragma unroll
                    for (int n = 0; n < 2; ++n)
#pragma unroll
                        for (int j = 0; j < 4; ++j) {
                            const float x = acc[ai][bj][m][n][j], xm1 = m > 0 ? acc[ai][bj][m - 1][n][j] : h[bj][n][j];
                            float p1 = dpp_prev(xm1, x, 1), p2 = dpp_prev(xm1, x, 2);
                            if (m == 0 && first) { if (fr == 2) { p1 = 0.f; p2 = 0.f; } if (fr == 3) p2 = 0.f; }
                            y[bj][4 * n + j] = W[bj][3][n][j] + W[bj][0][n][j] * p2 + W[bj][1][n][j] * p1 + W[bj][2][n][j] * x;
                        }
                float o[8];
#pragma unroll
                for (int c = 0; c < 8; ++c) { const float g = y[0][c];
                    const float e = __builtin_amdgcn_exp2f(g * (-2.3022081981f + -0.1029432397f * g * g));
                    o[c] = g * __builtin_amdgcn_rcpf(1.0f + e) * y[1][c]; }
                u32x4 w; w.x = cvt_pk_bf16(o[0], o[1]); w.y = cvt_pk_bf16(o[2], o[3]); w.z = cvt_pk_bf16(o[4], o[5]); w.w = cvt_pk_bf16(o[6], o[7]);
                if (r >= 2 && t < SEQ) *(u32x4*)(ffl + (size_t)t * DFF) = w;
            }
        }
    }
};

template <class Epi, class Sched, bool ALIGN_EPI>
__device__ __forceinline__ void gemm_phase(PG8_LAS unsigned char* lds, const int ld, const Sched& S, const Epi& E) {
    const int tid = threadIdx.x, wid = __builtin_amdgcn_readfirstlane(tid >> 6), lane = tid & 63, wr = wid >> 2, wc = wid & 3, fr = lane & 15, fq = lane >> 4;
    unsigned voffA[2], voffB[2];
#pragma unroll
    for (int i = 0; i < 2; ++i) { int R, C; stage_rc(tid * 16 + i * 8192, R, C); const int Rb = Epi::PERM ? ((R & ~31) + perm32(R & 31)) : R;
        voffA[i] = (unsigned)(R * ld + C) * 2u; voffB[i] = (unsigned)(Rb * ld + C) * 2u; }
    const size_t kstep = (size_t)(BK * 2);
    const size_t hstep = (size_t)HALF * ld * 2;
    const unsigned ldsw = (unsigned)wid * 1024u;
    const int aoff = lds_byte(wr * 64 + fr, fq * 8), boff = lds_byte(wc * 32 + fr, fq * 8);
#define PG8_SA(b, h) (((b) * 2 + (h)) * HTB)
#define PG8_SB(b, h) ((4 + (b) * 2 + (h)) * HTB)
#define PG8_STAGE(bufoff, gbase, voff) do { _Pragma("unroll") for (int _i = 0; _i < 2; ++_i) \
        __builtin_amdgcn_global_load_lds((const unsigned*)((const char*)(gbase) + (voff)[_i]), (PG8_LAS unsigned*)(lds + (bufoff) + ldsw + _i * 8192), 16, 0, 0); } while (0)
#define PG8_LDA(dst, b, h) do { _Pragma("unroll") for (int m = 0; m < 4; ++m) _Pragma("unroll") for (int k = 0; k < 2; ++k) dst[m][k] = *(const PG8_LAS bf16x8*)(lds + PG8_SA(b, h) + aoff + m * 2048 + k * 1024); } while (0)
#define PG8_LDB(dst, b, h) do { _Pragma("unroll") for (int n = 0; n < 2; ++n) _Pragma("unroll") for (int k = 0; k < 2; ++k) dst[n][k] = *(const PG8_LAS bf16x8*)(lds + PG8_SB(b, h) + boff + n * 2048 + k * 1024); } while (0)
#define PG8_MMA(ai, bj, At, Bt) do { __builtin_amdgcn_s_setprio(1); _Pragma("unroll") for (int m = 0; m < 4; ++m) _Pragma("unroll") for (int n = 0; n < 2; ++n) _Pragma("unroll") for (int k = 0; k < 2; ++k) \
        acc[ai][bj][m][n] = __builtin_amdgcn_mfma_f32_16x16x32_bf16(Bt[n][k], At[m][k], acc[ai][bj][m][n], 0, 0, 0); __builtin_amdgcn_s_setprio(0); } while (0)
#define PG8_WAIT_V(n) asm volatile("s_waitcnt vmcnt(" #n ")" ::: "memory")
#define PG8_WAIT_L(n) asm volatile("s_waitcnt lgkmcnt(" #n ")" ::: "memory")
#define PG8_BAR __builtin_amdgcn_s_barrier()
#define PG8_SCHED __builtin_amdgcn_sched_barrier(0)
    Unit cur, nxt; int ui = 0;
    if (!S.next(0, cur)) return;
    Ops oc = S.ops(cur);
    f32x4 acc[2][2][4][2];
#pragma unroll
    for (int a = 0; a < 2; ++a)
#pragma unroll
        for (int b = 0; b < 2; ++b)
#pragma unroll
            for (int m = 0; m < 4; ++m)
#pragma unroll
                for (int n = 0; n < 2; ++n) acc[a][b][m][n] = (f32x4){0.f, 0.f, 0.f, 0.f};
    bf16x8 At[4][2], B0[2][2], B1[2][2];
    const char* cA = oc.a; const char* cB = oc.b; int nt = oc.nt;
    PG8_STAGE(PG8_SB(0, 0), cB, voffB); PG8_STAGE(PG8_SB(0, 1), cB + hstep, voffB); PG8_STAGE(PG8_SA(0, 0), cA, voffA); PG8_STAGE(PG8_SA(0, 1), cA + hstep, voffA);
    if (wr == 1) PG8_BAR;
    PG8_WAIT_V(2); PG8_BAR;
    PG8_STAGE(PG8_SB(1, 0), cB + kstep, voffB); PG8_STAGE(PG8_SA(1, 0), cA + kstep, voffA); PG8_STAGE(PG8_SB(1, 1), cB + hstep + kstep, voffB);
    PG8_WAIT_V(6); PG8_BAR;
    for (;;) {
        const bool has_next = S.next(ui + 1, nxt);
        Ops on = oc; if (has_next) on = S.ops(nxt);
        const char* nA = on.a; const char* nB = on.b;
        for (int t = 0; t < nt; t += 2) {
            const bool last = (t == nt - 2);
            const char* a1 = cA + (size_t)(t + 1) * kstep;
            const char* a2 = last ? nA : cA + (size_t)(t + 2) * kstep; const char* b2 = last ? nB : cB + (size_t)(t + 2) * kstep;
            const char* a3 = a2 + kstep; const char* b3 = b2 + kstep;
            PG8_LDB(B0, 0, 0); PG8_LDB(B1, 0, 1); PG8_SCHED; PG8_LDA(At, 0, 0); PG8_STAGE(PG8_SA(1, 1), a1 + hstep, voffA);
            PG8_WAIT_V(8); PG8_WAIT_L(0); PG8_BAR; PG8_MMA(0, 0, At, B0); PG8_MMA(0, 1, At, B1); PG8_BAR; PG8_SCHED;
            PG8_LDA(At, 0, 1); PG8_STAGE(PG8_SB(0, 0), b2, voffB); PG8_STAGE(PG8_SB(0, 1), b2 + hstep, voffB); PG8_STAGE(PG8_SA(0, 0), a2, voffA);
            PG8_WAIT_V(8); PG8_WAIT_L(0); PG8_BAR; PG8_MMA(1, 0, At, B0); PG8_MMA(1, 1, At, B1); PG8_BAR; PG8_SCHED;
            PG8_LDB(B0, 1, 0); PG8_LDB(B1, 1, 1); PG8_SCHED; PG8_LDA(At, 1, 0); PG8_STAGE(PG8_SA(0, 1), a2 + hstep, voffA);
            PG8_WAIT_V(8); PG8_WAIT_L(0); PG8_BAR; PG8_MMA(0, 0, At, B0); PG8_MMA(0, 1, At, B1); PG8_BAR; PG8_SCHED;
            PG8_LDA(At, 1, 1); PG8_STAGE(PG8_SB(1, 0), b3, voffB); PG8_STAGE(PG8_SB(1, 1), b3 + hstep, voffB); PG8_STAGE(PG8_SA(1, 0), a3, voffA);
            PG8_WAIT_V(8); PG8_WAIT_L(0); PG8_BAR; PG8_MMA(1, 0, At, B0); PG8_MMA(1, 1, At, B1); PG8_BAR; PG8_SCHED;
        }
        if constexpr (ALIGN_EPI) { if (wr == 0) PG8_BAR; }
        E(acc, cur, wr, wc, fr, fq);
        if (!has_next) break;
#pragma unroll
        for (int a = 0; a < 2; ++a)
#pragma unroll
            for (int b = 0; b < 2; ++b)
#pragma unroll
                for (int m = 0; m < 4; ++m)
#pragma unroll
                    for (int n = 0; n < 2; ++n) acc[a][b][m][n] = (f32x4){0.f, 0.f, 0.f, 0.f};
        cur = nxt; oc = on; cA = nA; cB = nB; nt = on.nt; ++ui;
        if constexpr (ALIGN_EPI) { if (wr == 1) PG8_BAR; }
    }
    PG8_WAIT_V(0);
    if constexpr (!ALIGN_EPI) { if (wr == 0) PG8_BAR; }
    PG8_BAR;
#undef PG8_SA
#undef PG8_SB
#undef PG8_STAGE
#undef PG8_LDA
#undef PG8_LDB
#undef PG8_MMA
#undef PG8_WAIT_V
#undef PG8_WAIT_L
#undef PG8_BAR
#undef PG8_SCHED
}
}


namespace dat {
typedef short s16x4 __attribute__((ext_vector_type(4)));
typedef float f32x16 __attribute__((ext_vector_type(16)));
constexpr int NW = 8, QBLK = 32, KVBLK = 64, QB = NW * QBLK, PITCH = 1024;
constexpr int SHM_V = KVBLK * 128 * 2, SHM_K = KVBLK * 64 * 2;
constexpr int LDS_USED = 2 * SHM_V + 2 * SHM_K + NW * 64 * 4;
constexpr float THR = 8.f;
#define KSWZ(row, colB) ((row) * 128 + ((colB) ^ ((((row) >> 1) & 7) << 4)))
#define SBAR() __builtin_amdgcn_sched_barrier(0)
__device__ __forceinline__ int v_st(int k, int c) { const int kk = (k & ~0xC) | ((k & 4) << 1) | ((k & 8) >> 1); return ((kk >> 3) * 4 + (c >> 5)) * 512 + ((kk & 7) * 32 + (c & 31)) * 2; }
__device__ __forceinline__ int v_rd_base(int lane) { return ((lane & 3) << 3) | (((lane >> 2) & 3) << 6) | (((lane >> 4) & 1) << 5) | (((lane >> 5) & 1) << 8); }
constexpr int v_rd_off(int d0, int ks, int half) { return d0 * 512 + ks * 4096 + half * 2048; }
__device__ __forceinline__ int crow(int r, int hi) { return (r & 3) + 8 * (r >> 2) + 4 * hi; }
__device__ __forceinline__ unsigned cvtpk(float lo, float hi) { unsigned r; asm volatile("v_cvt_pk_bf16_f32 %0, %1, %2" : "=v"(r) : "v"(lo), "v"(hi)); return r; }

__device__ __forceinline__ void mask_tile(f32x16& p0, f32x16& p1, int dq) {
    const float NEG = -__builtin_inff();
#pragma unroll
    for (int r = 0; r < 16; ++r) { const int c = (r & 3) + 8 * (r >> 2); if (dq - c < 0) p0[r] = NEG; if (dq - c - 32 < 0) p1[r] = NEG; }
}
__device__ __forceinline__ void partialSM(f32x16& p0, f32x16& p1, float& m_reg, float& alpha) {
    float pmax = p0[0];
#pragma unroll
    for (int r = 1; r < 16; ++r) pmax = fmaxf(pmax, p0[r]);
#pragma unroll
    for (int r = 0; r < 16; ++r) pmax = fmaxf(pmax, p1[r]);
    { auto rr = __builtin_amdgcn_permlane32_swap(__float_as_uint(pmax), __float_as_uint(pmax), false, false);
      pmax = fmaxf(__uint_as_float(rr[0]), __uint_as_float(rr[1])); }
    float mn;
    if (__builtin_expect(__all(pmax - m_reg <= THR), 1)) { mn = m_reg; alpha = 1.f; }
    else { mn = fmaxf(m_reg, pmax); alpha = __builtin_amdgcn_exp2f(m_reg - mn); m_reg = mn; }
#pragma unroll
    for (int r = 0; r < 16; ++r) p0[r] = p0[r] - mn;
#pragma unroll
    for (int r = 0; r < 16; ++r) p1[r] = p1[r] - mn;
#pragma unroll
    for (int r = 0; r < 16; ++r) p0[r] = __builtin_amdgcn_exp2f(p0[r]);
}
__device__ __forceinline__ void finishSM(f32x16& p0, f32x16& p1, float alpha, float& l_reg, bf16x8& pa0, bf16x8& pa1, bf16x8& pa2, bf16x8& pa3) {
#pragma unroll
    for (int r = 0; r < 16; ++r) p1[r] = __builtin_amdgcn_exp2f(p1[r]);
    float ps = 0;
#pragma unroll
    for (int r = 0; r < 16; ++r) ps += p0[r];
#pragma unroll
    for (int r = 0; r < 16; ++r) ps += p1[r];
    { auto rr = __builtin_amdgcn_permlane32_swap(__float_as_uint(ps), __float_as_uint(ps), false, false);
      ps = __uint_as_float(rr[0]) + __uint_as_float(rr[1]); }
    l_reg = l_reg * alpha + ps;
#define PK4(P, B_, OUT) do { unsigned a0 = cvtpk(P[B_+0], P[B_+1]), a1 = cvtpk(P[B_+2], P[B_+3]);                          \
        unsigned b0 = cvtpk(P[B_+4], P[B_+5]), b1 = cvtpk(P[B_+6], P[B_+7]);                                             \
        auto r0 = __builtin_amdgcn_permlane32_swap(a0, b0, false, false); auto r1 = __builtin_amdgcn_permlane32_swap(a1, b1, false, false); \
        u32x4 w = {r0[0], r1[0], r0[1], r1[1]}; OUT = *reinterpret_cast<bf16x8*>(&w); } while (0)
    PK4(p0, 0, pa0); PK4(p0, 8, pa1); PK4(p1, 0, pa2); PK4(p1, 8, pa3);
#undef PK4
}
template <int KB>
__device__ __forceinline__ void qkt(f32x16& p0, f32x16& p1, const char* K_lds, int r32, int hi, const bf16x8* qr, float slope2, float off0) {
    const float off1 = off0 + 32.f * slope2;
#pragma unroll
    for (int r = 0; r < 16; ++r) { const float c = (float)((r & 3) + 8 * (r >> 2)); p0[r] = fmaf(slope2, c, off0); p1[r] = fmaf(slope2, c, off1); }
    const char* kb[4];
#pragma unroll
    for (int d0 = 0; d0 < 4; ++d0) kb[d0] = K_lds + KB * SHM_K + KSWZ(r32, (d0 * 16 + hi * 8) * 2);
#pragma unroll
    for (int d0 = 0; d0 < 4; ++d0) {
        bf16x8 b0 = *reinterpret_cast<const bf16x8*>(kb[d0]);
        bf16x8 b1 = *reinterpret_cast<const bf16x8*>(kb[d0] + 32 * 128);
        p0 = __builtin_amdgcn_mfma_f32_32x32x16_bf16(b0, qr[d0], p0, 0, 0, 0);
        p1 = __builtin_amdgcn_mfma_f32_32x32x16_bf16(b1, qr[d0], p1, 0, 0, 0); }
}
template <int VB>
__device__ __forceinline__ void pv_tile(f32x16* o, int vb0, bf16x8 pa0, bf16x8 pa1, bf16x8 pa2, bf16x8 pa3) {
#define TRRD(dst, off) asm volatile("ds_read_b64_tr_b16 %0, %1 offset:%2" : "=&v"(dst) : "v"(vb0), "i"(off) : "memory")
#define PV_D0(d0) do { s16x4 l0, l1, l2, l3, h0, h1, h2, h3; constexpr int b_ = VB * SHM_V + v_rd_off(d0, 0, 0);   \
        TRRD(l0, b_); TRRD(h0, b_ + 2048); TRRD(l1, b_ + 4096); TRRD(h1, b_ + 6144); TRRD(l2, b_ + 8192); TRRD(h2, b_ + 10240); TRRD(l3, b_ + 12288); TRRD(h3, b_ + 14336); \
        asm volatile("s_waitcnt lgkmcnt(0)" ::: "memory"); SBAR();   \
        o[d0] = __builtin_amdgcn_mfma_f32_32x32x16_bf16(pa0, (bf16x8){l0[0], l0[1], l0[2], l0[3], h0[0], h0[1], h0[2], h0[3]}, o[d0], 0, 0, 0);   \
        o[d0] = __builtin_amdgcn_mfma_f32_32x32x16_bf16(pa1, (bf16x8){l1[0], l1[1], l1[2], l1[3], h1[0], h1[1], h1[2], h1[3]}, o[d0], 0, 0, 0);   \
        o[d0] = __builtin_amdgcn_mfma_f32_32x32x16_bf16(pa2, (bf16x8){l2[0], l2[1], l2[2], l2[3], h2[0], h2[1], h2[2], h2[3]}, o[d0], 0, 0, 0);   \
        o[d0] = __builtin_amdgcn_mfma_f32_32x32x16_bf16(pa3, (bf16x8){l3[0], l3[1], l3[2], l3[3], h3[0], h3[1], h3[2], h3[3]}, o[d0], 0, 0, 0); } while (0)
    PV_D0(0); PV_D0(1); PV_D0(2); PV_D0(3);
#undef PV_D0
#undef TRRD
}
struct BlockRef { const bf16_t* Q; const bf16_t* K; const bf16_t* V; int P0; };
__device__ __forceinline__ void diff_block(const int MODE, const BlockRef& cur, float slope2, float lam, f32x4* stash, bf16_t* O, char* lds) {
    int tid_ = threadIdx.x; asm volatile("" : "+v"(tid_));
    const int tid = tid_, wid = __builtin_amdgcn_readfirstlane(tid >> 6), lane = tid & 63, r32 = lane & 31, hi = lane >> 5;
    const int NT = (cur.P0 + QB) / KVBLK;
    const int qlo = cur.P0 + wid * QBLK, qm = qlo + r32 - 4 * hi;
    char* V_lds = lds; char* K_lds = lds + 2 * SHM_V;
    float* wsf = (float*)(lds + 2 * SHM_V + 2 * SHM_K) + wid * 64; float* li_l = wsf, * al_l = wsf + 32;
    float m_reg = -1e30f, l_reg = 0; f32x16 o[4] = {};
    const int sr = tid >> 4, sc = (tid & 15) * 8, vst0 = v_st(sr, sc), vst1 = v_st(32 + sr, sc);
    const int kr = tid >> 3, kc = (tid & 7) * 8, kws = KSWZ(kr, kc * 2);
    const int vb0 = (int)(uintptr_t)V_lds + v_rd_base(lane);
    const bf16_t* Kh = cur.K; const bf16_t* Vh = cur.V;
    bf16x8 st_v0, st_v1, st_k0;
#define KBASE(t) ((NT - 1 - (t)) * KVBLK)
#define SLOAD(t) do { const int k0_ = KBASE(t); st_v0 = *(const bf16x8*)(Vh + (size_t)(k0_ + sr) * PITCH + sc); st_v1 = *(const bf16x8*)(Vh + (size_t)(k0_ + 32 + sr) * PITCH + sc); \
                      st_k0 = *(const bf16x8*)(Kh + (size_t)(k0_ + kr) * PITCH + kc); } while (0)
#define SWRITE_K(bf) do { *(bf16x8*)(K_lds + (bf) * SHM_K + kws) = st_k0; } while (0)
#define SWRITE_V(bf) do { *(bf16x8*)(V_lds + (bf) * SHM_V + vst0) = st_v0; *(bf16x8*)(V_lds + (bf) * SHM_V + vst1) = st_v1; } while (0)
#define VMW() asm volatile("s_waitcnt vmcnt(0)" ::: "memory")
#define RESC(a) do { if (__any((a) < 1.f)) { if (hi == 0) al_l[r32] = (a); asm volatile("s_waitcnt lgkmcnt(0)" ::: "memory");              \
                     _Pragma("unroll") for (int d_ = 0; d_ < 4; ++d_) _Pragma("unroll") for (int r = 0; r < 16; ++r) o[d_][r] *= al_l[crow(r, hi)]; } } while (0)
#define OFF0(t) (slope2 * (float)(KBASE(t) + 4 * hi - (qlo + r32)))
#define MASKT(P0_, P1_, t) do { const int kb_ = KBASE(t); if (kb_ + KVBLK - 1 > qlo) mask_tile(P0_, P1_, qm - kb_); } while (0)
    bf16x8 qr[4];
#pragma unroll
    for (int d0 = 0; d0 < 4; ++d0) qr[d0] = *(const bf16x8*)(cur.Q + (size_t)(wid * QBLK + r32) * PITCH + d0 * 16 + hi * 8);
    SLOAD(0); VMW(); SWRITE_K(0); SWRITE_V(0); SBAR();
    if (NT > 1) SLOAD(1);
    __syncthreads();
    f32x16 pA0, pA1, pB0, pB1; float alA, alB; bf16x8 pa0, pa1, pa2, pa3;
    SBAR(); qkt<0>(pA0, pA1, K_lds, r32, hi, qr, slope2, OFF0(0));
    MASKT(pA0, pA1, 0); partialSM(pA0, pA1, m_reg, alA);
    if (NT > 1) { VMW(); SWRITE_K(1); SWRITE_V(1); }
    __syncthreads();
#define HALF_STEP(PX0, PX1, alX, PY0, PY1, alY, t, KB, VB, SB) do {                                                      \
        SBAR(); qkt<KB>(PX0, PX1, K_lds, r32, hi, qr, slope2, OFF0(t));                                                  \
        finishSM(PY0, PY1, alY, l_reg, pa0, pa1, pa2, pa3); SBAR();                                                      \
        if ((t) + 1 < NT) { SLOAD((t) + 1); SBAR(); }                                                                    \
        pv_tile<VB>(o, vb0, pa0, pa1, pa2, pa3); MASKT(PX0, PX1, (t)); partialSM(PX0, PX1, m_reg, alX);                  \
        __syncthreads();                                                                                                 \
        if ((t) + 1 < NT) { VMW(); SWRITE_K(SB); SWRITE_V(SB); }                                                         \
        RESC(alX); __syncthreads(); } while (0)
    for (int t = 1; t + 1 < NT; t += 2) {
        HALF_STEP(pB0, pB1, alB, pA0, pA1, alA, t, 1, 0, 0);
        HALF_STEP(pA0, pA1, alA, pB0, pB1, alB, t + 1, 0, 1, 1);
    }
    SBAR(); qkt<1>(pB0, pB1, K_lds, r32, hi, qr, slope2, OFF0(NT - 1)); SBAR();
    finishSM(pA0, pA1, alA, l_reg, pa0, pa1, pa2, pa3); SBAR();
    pv_tile<0>(o, vb0, pa0, pa1, pa2, pa3);
    MASKT(pB0, pB1, NT - 1); partialSM(pB0, pB1, m_reg, alB); RESC(alB);
    finishSM(pB0, pB1, alB, l_reg, pa0, pa1, pa2, pa3); SBAR(); pv_tile<1>(o, vb0, pa0, pa1, pa2, pa3);
    if (hi == 0) li_l[r32] = l_reg; asm volatile("s_waitcnt lgkmcnt(0)" ::: "memory");
    float rli[16];
#pragma unroll
    for (int r = 0; r < 16; ++r) rli[r] = __builtin_amdgcn_rcpf(li_l[crow(r, hi)]);
    if (MODE == 0) {
#pragma unroll
        for (int d0 = 0; d0 < 4; ++d0)
#pragma unroll
            for (int g = 0; g < 4; ++g) { f32x4 v; v[0] = o[d0][4 * g] * rli[4 * g]; v[1] = o[d0][4 * g + 1] * rli[4 * g + 1]; v[2] = o[d0][4 * g + 2] * rli[4 * g + 2]; v[3] = o[d0][4 * g + 3] * rli[4 * g + 3];
                stash[(size_t)(d0 * 4 + g) * 512 + tid] = v; }
    } else {
        float ss[16];
#pragma unroll
        for (int r = 0; r < 16; ++r) ss[r] = 0.f;
#pragma unroll
        for (int d0 = 0; d0 < 4; ++d0)
#pragma unroll
            for (int g = 0; g < 4; ++g) { const f32x4 s1 = stash[(size_t)(d0 * 4 + g) * 512 + tid];
#pragma unroll
                for (int j = 0; j < 4; ++j) { const int r = 4 * g + j; const float a = s1[j] - lam * (o[d0][r] * rli[r]); o[d0][r] = a; ss[r] += a * a; } }
#pragma unroll
        for (int r = 0; r < 16; ++r) {
#pragma unroll
            for (int x = 1; x < 32; x <<= 1) ss[r] += __shfl_xor(ss[r], x);
            ss[r] = 1.0f / sqrtf(ss[r] * (1.0f / 128.0f) + EPS); }
        bf16_t* Ow = O + (size_t)(wid * QBLK) * PITCH;
#pragma unroll
        for (int r = 0; r < 16; ++r) { const int orow = crow(r, hi);
#pragma unroll
            for (int d0 = 0; d0 < 4; ++d0) { const float v = o[d0][r] * ss[r]; const float vn = __shfl_xor(v, 1);
                if ((r32 & 1) == 0) *(unsigned*)(Ow + (size_t)orow * PITCH + d0 * 32 + r32) = cvtpk(v, vn); } }
    }
    __syncthreads();
#undef KBASE
#undef SLOAD
#undef SWRITE_K
#undef SWRITE_V
#undef VMW
#undef RESC
#undef OFF0
#undef MASKT
#undef HALF_STEP
}
#undef KSWZ
#undef SBAR
}

struct SrcIn {
    const float* w; const float* g; const float* pw;
    __device__ __forceinline__ float operator()(int k, int n) const {
        const float gk = g[k]; const float* row = w + (size_t)k * INC;
        if (n >= 3072 && n < 3584) { const int grp = (n - 3072) >> 7, d = (n - 3072) & 127; const float* wr = row + 3072 + grp * 128; const float* p = pw + (size_t)grp * 128 * 128 + d;
            float s = 0.f;
            for (int c = 0; c < 128; ++c) s += wr[c] * p[(size_t)c * 128];
            return s * gk; }
        float v = row[n] * gk;
        if (n < 1024) v *= C2Q; else if (n >= 3584 && n < 4096) v *= C2M;
        return v;
    }
};
struct SrcAtt { const float* w; const float* g; __device__ __forceinline__ float operator()(int k, int n) const { return w[(size_t)k * DM + n] * g[k & 127] * (1.0f - LAM_INIT); } };
struct SrcPool { const float* w; const float* g; __device__ __forceinline__ float operator()(int k, int n) const { return w[(size_t)k * DM + n] * g[k]; } };
struct SrcPlain { const float* w; int N; __device__ __forceinline__ float operator()(int k, int n) const { return w[(size_t)k * N + n]; } };
struct SrcGainK { const float* w; const float* g; int N; __device__ __forceinline__ float operator()(int k, int n) const { return w[(size_t)k * N + n] * g[k]; } };
struct SrcUp {
    const float* w; const float* g;
    __device__ __forceinline__ float operator()(int k, int n) const { const int j = n >> 8, s = (n >> 7) & 1, cc = n & 127; return w[(size_t)k * DFF2 + s * DFF + 128 * j + cc] * g[k]; }
};
template <class F>
__device__ __forceinline__ void transpose_item(const F& src, int K, int N, bf16_t* WT, int ldt, int koff, LAS float* scr, int item, int lane) {
    const int nblk = N / 32, kb = item / nblk, nb = item % nblk, k0 = 64 * kb, n0 = 32 * nb;
    for (int i = 0; i < 32; ++i) { const int kk = 2 * i + (lane >> 5); scr[kk * 33 + (lane & 31)] = src(k0 + kk, n0 + (lane & 31)); }
    asm volatile("s_waitcnt lgkmcnt(0)" ::: "memory");
    const int c = lane & 7;
#pragma unroll
    for (int j = 0; j < 4; ++j) { const int n = (lane >> 3) + 8 * j; const LAS float* s = scr + (8 * c) * 33 + n;
        u32x4 o; o.x = pk2(s[0 * 33], s[1 * 33]); o.y = pk2(s[2 * 33], s[3 * 33]); o.z = pk2(s[4 * 33], s[5 * 33]); o.w = pk2(s[6 * 33], s[7 * 33]);
        *(u32x4*)(WT + (size_t)(n0 + n) * ldt + koff + k0 + 8 * c) = o; }
    asm volatile("s_waitcnt lgkmcnt(0)" ::: "memory");
}
__device__ __forceinline__ void rms_row_to_bf16(const float* xrow, bf16_t* orow, int lane) {
    const f32x4* xr = (const f32x4*)xrow + lane; f32x4 v[4]; float s = 0.f;
#pragma unroll
    for (int j = 0; j < 4; ++j) { v[j] = xr[64 * j]; s += (v[j].x * v[j].x + v[j].y * v[j].y) + (v[j].z * v[j].z + v[j].w * v[j].w); }
    const float rstd = 1.0f / sqrtf(wave_sum(s) * (1.0f / DM) + EPS);
    u32x2* o8 = (u32x2*)orow + lane;
#pragma unroll
    for (int j = 0; j < 4; ++j) { u32x2 w; w.x = pk2(v[j].x * rstd, v[j].y * rstd); w.y = pk2(v[j].z * rstd, v[j].w * rstd); o8[64 * j] = w; }
}

__device__ __forceinline__ void phase0(const Params& p, LAS unsigned char* lds, int gw, int NGW, int wave, int lane) {
    LAS float* scr = (LAS float*)(lds + wave * 16384);
    unsigned char* ws = p.ws;
    const SrcIn sIn{p.in[3], p.in[2], p.in[10]};
    const SrcAtt sAtt{p.in[9], p.in[8]};
    const SrcPool sPool{p.in[12], p.in[11]};
    const SrcPlain sMemB{p.in[15], DM};
    const SrcGainK sMkv{p.in[14], p.in[13], DM};
    const SrcPlain sOut{p.in[16], DM};
    const SrcUp sUp{p.in[19], p.in[18]};
    const SrcPlain sDn{p.in[22], DM};
    constexpr int I_IN = (DM / 64) * (INC / 32), I_SQ = (DM / 64) * (DM / 32), I_H = (512 / 64) * (DM / 32), I_UP = (DM / 64) * (DFF2 / 32), I_DN = (DFF / 64) * (DM / 32);
    constexpr int NITEMS = I_IN + I_SQ + 2 * I_H + I_SQ + I_SQ + I_UP + I_DN;
    for (int it = gw; it < NITEMS; it += NGW) {
        int r = it;
        if (r < I_IN) { transpose_item(sIn, DM, INC, (bf16_t*)(ws + WS_WIN), DM, 0, scr, r, lane); continue; } r -= I_IN;
        if (r < I_SQ) { transpose_item(sAtt, DM, DM, (bf16_t*)(ws + WS_WATT), DM, 0, scr, r, lane); continue; } r -= I_SQ;
        if (r < I_H) { transpose_item(sPool, 512, DM, (bf16_t*)(ws + WS_WPM), DM, 0, scr, r, lane); continue; } r -= I_H;
        if (r < I_H) { transpose_item(sMemB, 512, DM, (bf16_t*)(ws + WS_WPM), DM, 512, scr, r, lane); continue; } r -= I_H;
        if (r < I_SQ) { transpose_item(sMkv, DM, DM, (bf16_t*)(ws + WS_WMKV), DM, 0, scr, r, lane); continue; } r -= I_SQ;
        if (r < I_SQ) { transpose_item(sOut, DM, DM, (bf16_t*)(ws + WS_WOUT), DM, 0, scr, r, lane); continue; } r -= I_SQ;
        if (r < I_UP) { transpose_item(sUp, DM, DFF2, (bf16_t*)(ws + WS_WUP), DM, 0, scr, r, lane); continue; } r -= I_UP;
        transpose_item(sDn, DFF, DM, (bf16_t*)(ws + WS_WDN), DFF, 0, scr, r, lane);
    }
    for (int m = gw; m < TOK; m += NGW) rms_row_to_bf16(p.in[0] + (size_t)m * DM, (bf16_t*)(ws + WS_XN) + (size_t)m * DM, lane);
    for (int m = gw; m < BATCH * MEMTOK; m += NGW) rms_row_to_bf16(p.in[1] + (size_t)m * DM, (bf16_t*)(ws + WS_MEMN) + (size_t)m * DM, lane);
}

__device__ __forceinline__ void phase1(const Params& p, int gw, int NGW, int lane) {
    unsigned char* ws = p.ws;
    const bf16_t* xn = (const bf16_t*)(ws + WS_XN); const bf16_t* win = (const bf16_t*)(ws + WS_WIN);
    bf16_t* qb = (bf16_t*)p.out; bf16_t* kb = qb + (size_t)TOK * DM; bf16_t* vb = (bf16_t*)(ws + WS_V);
    bf16_t* upf = (bf16_t*)(ws + WS_UPF); bf16_t* qm = (bf16_t*)(ws + WS_QM);
    const int fr = lane & 15, fq = lane >> 4;
    constexpr int NT1 = (TOK / 32) * (4096 / 32), NT2 = (512 / 32) * (1024 / 32);
    for (int t = gw; t < NT1 + NT2; t += NGW) {
        f32x4 acc[2][2]; zero_acc(acc);
        if (t < NT1) {
            const int mt = t / 128, nt = t % 128, r0 = mt * 32, c0 = nt * 32;
            wave_gemm<2, 2>(xn, DM, win, DM, DM, r0, c0, acc, lane);
            bf16_t* dst; int ld, cc;
            if (c0 < 1024) { dst = qb; ld = DM; cc = c0; } else if (c0 < 2048) { dst = kb; ld = DM; cc = c0 - 1024; } else if (c0 < 3072) { dst = vb; ld = DM; cc = c0 - 2048; }
            else if (c0 < 3584) { dst = upf; ld = 512; cc = c0 - 3072; } else { dst = qm; ld = 512; cc = c0 - 3584; }
#pragma unroll
            for (int mi = 0; mi < 2; ++mi)
#pragma unroll
                for (int ni = 0; ni < 2; ++ni)
#pragma unroll
                    for (int j = 0; j < 4; ++j) dst[(size_t)(r0 + 16 * mi + 4 * fq + j) * ld + cc + 16 * ni + fr] = (bf16_t)f2bf(acc[mi][ni][j]);
        } else {
            const int tt = t - NT1, mt = tt / 32, nt = tt % 32, r0 = mt * 32, c0 = nt * 32;
            wave_gemm<2, 2>((const bf16_t*)(ws + WS_MEMN), DM, (const bf16_t*)(ws + WS_WMKV), DM, DM, r0, c0, acc, lane);
            bf16_t* dst = (bf16_t*)(ws + WS_KVM);
#pragma unroll
            for (int mi = 0; mi < 2; ++mi)
#pragma unroll
                for (int ni = 0; ni < 2; ++ni)
#pragma unroll
                    for (int j = 0; j < 4; ++j) dst[(size_t)(r0 + 16 * mi + 4 * fq + j) * DM + c0 + 16 * ni + fr] = (bf16_t)f2bf(acc[mi][ni][j]);
        }
    }
}

__device__ __forceinline__ float lam_value(const Params& p) {
    float s1 = 0.f, s2 = 0.f;
    for (int i = 0; i < 64; ++i) { s1 += p.in[4][i] * p.in[5][i]; s2 += p.in[6][i] * p.in[7][i]; }
    return expf(s1) - expf(s2) + LAM_INIT;
}
__device__ __forceinline__ void load16(const bf16_t* p, float* o) {
    const u32x4 a = *(const u32x4*)p, b = *(const u32x4*)(p + 8);
    const unsigned w[8] = {a.x, a.y, a.z, a.w, b.x, b.y, b.z, b.w};
#pragma unroll
    for (int i = 0; i < 8; ++i) { o[2 * i] = __uint_as_float(w[i] << 16); o[2 * i + 1] = __uint_as_float(w[i] & 0xffff0000u); }
}
__device__ __forceinline__ void phase2_diff(const Params& p, int gw, int NGW, int lane) {
    unsigned char* ws = p.ws;
    const bf16_t* Q = (const bf16_t*)p.out; const bf16_t* Kb = Q + (size_t)TOK * DM; const bf16_t* Vb = (const bf16_t*)(ws + WS_V);
    bf16_t* an = (bf16_t*)(ws + WS_AN);
    const float lam = lam_value(p);
    const int sub = lane & 3, qi = lane >> 2;
    for (int r = 0; r * NGW + gw < 8192; ++r) {
        const int ig = r * NGW + gw, h = ig & 7, tq = ig >> 3, b = tq >> 9; int tg = tq & 511; if (tg & 256) tg = 767 - tg;
        const int t = tg * 16 + qi; const size_t gm = (size_t)b * SEQ + t;
        const float slope2 = exp2f(-(float)(h + 1)) * LOG2E;
        float o1[32];
        float oo[32];
#pragma unroll
        for (int c = 0; c < 2; ++c) {
            float qv[16]; load16(Q + gm * DM + h * 128 + c * 64 + sub * 16, qv);
            float m = -1e30f, l = 0.f;
#pragma unroll
            for (int e = 0; e < 32; ++e) oo[e] = 0.f;
            const int tmax = tg * 16 + 15;
            const bf16_t* kp = Kb + (size_t)b * SEQ * DM + h * 128 + c * 64 + sub * 16;
            const bf16_t* vp = Vb + (size_t)b * SEQ * DM + h * 128 + sub * 32;
            for (int j = 0; j <= tmax; ++j) {
                float kv[16]; load16(kp + (size_t)j * DM, kv);
                float s = 0.f;
#pragma unroll
                for (int d = 0; d < 16; ++d) s += qv[d] * kv[d];
                s += __shfl_xor(s, 1); s += __shfl_xor(s, 2);
                s -= slope2 * (float)(t - j);
                const bool valid = j <= t;
                const float mn = valid ? fmaxf(m, s) : m;
                const float alpha = __builtin_amdgcn_exp2f(m - mn);
                const float pr = valid ? __builtin_amdgcn_exp2f(s - mn) : 0.f;
                l = l * alpha + pr; m = mn;
                float vv[32]; load16(vp + (size_t)j * DM, vv); load16(vp + (size_t)j * DM + 16, vv + 16);
#pragma unroll
                for (int e = 0; e < 32; ++e) oo[e] = oo[e] * alpha + pr * vv[e];
            }
            const float il = 1.0f / l;
            if (c == 0) {
#pragma unroll
                for (int e = 0; e < 32; ++e) o1[e] = oo[e] * il;
            } else {
#pragma unroll
                for (int e = 0; e < 32; ++e) oo[e] = o1[e] - lam * (oo[e] * il);
            }
        }
        float ss = 0.f;
#pragma unroll
        for (int e = 0; e < 32; ++e) ss += oo[e] * oo[e];
        ss += __shfl_xor(ss, 1); ss += __shfl_xor(ss, 2);
        const float rstd = 1.0f / sqrtf(ss * (1.0f / 128.0f) + EPS);
        bf16_t* dst = an + gm * DM + h * 128 + sub * 32;
#pragma unroll
        for (int e = 0; e < 32; e += 2) *(unsigned*)(dst + e) = pk2(oo[e] * rstd, oo[e + 1] * rstd);
    }
}
__device__ __forceinline__ void phase2_mem(const Params& p, int gw, int NGW, int lane) {
    unsigned char* ws = p.ws;
    const bf16_t* qm = (const bf16_t*)(ws + WS_QM); const bf16_t* kvm = (const bf16_t*)(ws + WS_KVM); bf16_t* po = (bf16_t*)(ws + WS_PO);
    const int sub = lane & 3, qi = lane >> 2;
    for (int ig = gw; ig < (TOK / 16) * NMEMH; ig += NGW) {
        const int h = ig & 3, tq = ig >> 2; const size_t gm = (size_t)tq * 16 + qi; const int b = (int)(gm / SEQ);
        float qv[32]; load16(qm + gm * 512 + h * 128 + sub * 32, qv); load16(qm + gm * 512 + h * 128 + sub * 32 + 16, qv + 16);
        float m = -1e30f, l = 0.f, oo[32];
#pragma unroll
        for (int e = 0; e < 32; ++e) oo[e] = 0.f;
        const bf16_t* kp = kvm + (size_t)b * MEMTOK * DM + h * 128 + sub * 32;
        for (int j = 0; j < MEMTOK; ++j) {
            float kv[32]; load16(kp + (size_t)j * DM, kv); load16(kp + (size_t)j * DM + 16, kv + 16);
            float s = 0.f;
#pragma unroll
            for (int d = 0; d < 32; ++d) s += qv[d] * kv[d];
            s += __shfl_xor(s, 1); s += __shfl_xor(s, 2);
            const float mn = fmaxf(m, s), alpha = __builtin_amdgcn_exp2f(m - mn), pr = __builtin_amdgcn_exp2f(s - mn);
            l = l * alpha + pr; m = mn;
            float vv[32]; load16(kp + (size_t)j * DM + 512, vv); load16(kp + (size_t)j * DM + 512 + 16, vv + 16);
#pragma unroll
            for (int e = 0; e < 32; ++e) oo[e] = oo[e] * alpha + pr * vv[e];
        }
        const float il = 1.0f / l;
        bf16_t* dst = po + gm * DM + 512 + h * 128 + sub * 32;
#pragma unroll
        for (int e = 0; e < 32; e += 2) *(unsigned*)(dst + e) = pk2(oo[e] * il, oo[e + 1] * il);
    }
}
__device__ __forceinline__ void phase2_pool(const Params& p, int gtid, int NGT) {
    unsigned char* ws = p.ws;
    const bf16_t* upf = (const bf16_t*)(ws + WS_UPF); bf16_t* po = (bf16_t*)(ws + WS_PO);
    for (size_t i = gtid; i < (size_t)TOK * 512; i += NGT) {
        const int c = (int)(i & 511); const size_t gm = i >> 9; const int t = (int)(gm & (SEQ - 1)); const int w = 2 << (c >> 7);
        const int lo = t + 1 - w > 0 ? t + 1 - w : 0; const int cnt = t + 1 < w ? t + 1 : w;
        float s = 0.f;
        for (int j = lo; j <= t; ++j) s += bf2f(upf[(gm - t + j) * 512 + c]);
        po[gm * DM + c] = (bf16_t)f2bf(s / (float)cnt - bf2f(upf[gm * 512 + c]));
    }
}

__device__ __forceinline__ void phase3(const Params& p, int gw, int NGW, int lane) {
    unsigned char* ws = p.ws;
    const bf16_t* xn = (const bf16_t*)(ws + WS_XN); const bf16_t* win = (const bf16_t*)(ws + WS_WIN);
    const bf16_t* an = (const bf16_t*)(ws + WS_AN); const bf16_t* po = (const bf16_t*)(ws + WS_PO);
    const bf16_t* watt = (const bf16_t*)(ws + WS_WATT); const bf16_t* wpm = (const bf16_t*)(ws + WS_WPM);
    bf16_t* mix = (bf16_t*)(ws + WS_MIX);
    const int fr = lane & 15, fq = lane >> 4;
    for (int t = gw; t < (TOK / 32) * (DM / 32); t += NGW) {
        const int mt = t / 32, nt = t % 32, r0 = mt * 32, c0 = nt * 32;
        f32x4 mx[2][2]; zero_acc(mx);
#pragma unroll
        for (int i = 0; i < 3; ++i) {
            f32x4 ag[2][2], ay[2][2]; zero_acc(ag); zero_acc(ay);
            wave_gemm<2, 2>(xn, DM, win + (size_t)(4096 + i * 1024) * DM, DM, DM, r0, c0, ag, lane);
            if (i == 0) wave_gemm<2, 2>(an, DM, watt, DM, DM, r0, c0, ay, lane);
            else if (i == 1) wave_gemm<2, 2>(po, DM, wpm, DM, 512, r0, c0, ay, lane);
            else wave_gemm<2, 2>(po + 512, DM, wpm + 512, DM, 512, r0, c0, ay, lane);
#pragma unroll
            for (int mi = 0; mi < 2; ++mi)
#pragma unroll
                for (int ni = 0; ni < 2; ++ni)
#pragma unroll
                    for (int j = 0; j < 4; ++j) mx[mi][ni][j] += sigmoidf_(ag[mi][ni][j]) * ay[mi][ni][j];
        }
#pragma unroll
        for (int mi = 0; mi < 2; ++mi)
#pragma unroll
            for (int ni = 0; ni < 2; ++ni)
#pragma unroll
                for (int j = 0; j < 4; ++j) mix[(size_t)(r0 + 16 * mi + 4 * fq + j) * DM + c0 + 16 * ni + fr] = (bf16_t)f2bf(mx[mi][ni][j]);
    }
}

__device__ __forceinline__ void gemm_f32out(const bf16_t* A, int lda, const bf16_t* Bt, int ldb, int K, int M, int N, float* C, int gw, int NGW, int lane) {
    const int fr = lane & 15, fq = lane >> 4; const int ntn = N / 32;
    for (int t = gw; t < (M / 32) * ntn; t += NGW) {
        const int mt = t / ntn, nt = t % ntn, r0 = mt * 32, c0 = nt * 32;
        f32x4 acc[2][2]; zero_acc(acc);
        wave_gemm<2, 2>(A, lda, Bt, ldb, K, r0, c0, acc, lane);
#pragma unroll
        for (int mi = 0; mi < 2; ++mi)
#pragma unroll
            for (int ni = 0; ni < 2; ++ni)
#pragma unroll
                for (int j = 0; j < 4; ++j) C[(size_t)(r0 + 16 * mi + 4 * fq + j) * N + c0 + 16 * ni + fr] = acc[mi][ni][j];
    }
}
__device__ __forceinline__ void norm_res_rows(const float* z, const float* base, const float* g, float* out, bf16_t* xn2, int gw, int NGW, int lane) {
    for (int m = gw; m < TOK; m += NGW) {
        const f32x4* zr = (const f32x4*)(z + (size_t)m * DM) + lane; const f32x4* br = (const f32x4*)(base + (size_t)m * DM) + lane; const f32x4* gr = (const f32x4*)g + lane;
        f32x4 v[4]; float s = 0.f;
#pragma unroll
        for (int j = 0; j < 4; ++j) { v[j] = zr[64 * j]; s += (v[j].x * v[j].x + v[j].y * v[j].y) + (v[j].z * v[j].z + v[j].w * v[j].w); }
        const float rstd = 1.0f / sqrtf(wave_sum(s) * (1.0f / DM) + EPS);
        float s2 = 0.f;
#pragma unroll
        for (int j = 0; j < 4; ++j) { v[j] = br[64 * j] + v[j] * rstd * gr[64 * j]; s2 += (v[j].x * v[j].x + v[j].y * v[j].y) + (v[j].z * v[j].z + v[j].w * v[j].w); }
        f32x4* orow = (f32x4*)(out + (size_t)m * DM) + lane;
#pragma unroll
        for (int j = 0; j < 4; ++j) orow[64 * j] = v[j];
        if (xn2) {
            const float r2 = 1.0f / sqrtf(wave_sum(s2) * (1.0f / DM) + EPS);
            u32x2* o8 = (u32x2*)(xn2 + (size_t)m * DM) + lane;
#pragma unroll
            for (int j = 0; j < 4; ++j) { u32x2 w; w.x = pk2(v[j].x * r2, v[j].y * r2); w.y = pk2(v[j].z * r2, v[j].w * r2); o8[64 * j] = w; }
        }
    }
}

__device__ __forceinline__ void phase5(const Params& p, LAS unsigned char* lds, int gw, int NGW, int wave, int lane) {
    unsigned char* ws = p.ws;
    const bf16_t* xn2 = (const bf16_t*)(ws + WS_XN2); const bf16_t* wup = (const bf16_t*)(ws + WS_WUP); bf16_t* ff = (bf16_t*)(ws + WS_FF);
    const float* cw = p.in[20]; const float* cb = p.in[21];
    LAS float* scr = (LAS float*)(lds + wave * 16384);
    const int fr = lane & 15, fq = lane >> 4;
    for (int t = gw; t < (TOK / 32) * (DFF / 32); t += NGW) {
        const int mt = t / 88, ct = t % 88, m0 = mt * 32, ch0 = ct * 32;
        const int grow = 256 * (ch0 >> 7) + (ch0 & 127);
        f32x4 ag[3][2], av[3][2]; zero_acc(ag); zero_acc(av);
        wave_gemm<3, 2>(xn2, DM, wup, DM, DM, m0 - 16, grow, ag, lane);
        wave_gemm<3, 2>(xn2, DM, wup, DM, DM, m0 - 16, grow + 128, av, lane);
#pragma unroll
        for (int mi = 0; mi < 3; ++mi)
#pragma unroll
            for (int ni = 0; ni < 2; ++ni)
#pragma unroll
                for (int j = 0; j < 4; ++j) { const int rr = 16 * mi + 4 * fq + j; scr[rr * 64 + 16 * ni + fr] = ag[mi][ni][j]; scr[rr * 64 + 32 + 16 * ni + fr] = av[mi][ni][j]; }
        asm volatile("s_waitcnt lgkmcnt(0)" ::: "memory");
        const int c = lane & 31, ch = ch0 + c;
        const float wg0 = cw[ch], wg1 = cw[DFF2 + ch], wg2 = cw[2 * DFF2 + ch], bg = cb[ch];
        const float wv0 = cw[DFF + ch], wv1 = cw[DFF2 + DFF + ch], wv2 = cw[2 * DFF2 + DFF + ch], bv = cb[DFF + ch];
        for (int i = 0; i < 16; ++i) {
            const int r = (lane >> 5) + 2 * i, m = m0 + r, tt = m & (SEQ - 1);
            const float g2 = scr[(16 + r) * 64 + c], g1 = tt >= 1 ? scr[(15 + r) * 64 + c] : 0.f, g0 = tt >= 2 ? scr[(14 + r) * 64 + c] : 0.f;
            const float v2 = scr[(16 + r) * 64 + 32 + c], v1 = tt >= 1 ? scr[(15 + r) * 64 + 32 + c] : 0.f, v0 = tt >= 2 ? scr[(14 + r) * 64 + 32 + c] : 0.f;
            const float cgv = bg + wg0 * g0 + wg1 * g1 + wg2 * g2, cvv = bv + wv0 * v0 + wv1 * v1 + wv2 * v2;
            ff[(size_t)m * DFF + ch] = (bf16_t)f2bf(gelu_tanh(cgv) * cvv);
        }
        asm volatile("s_waitcnt lgkmcnt(0)" ::: "memory");
    }
}

__global__ void __launch_bounds__(NTHREADS, 2) mega_fwd(Params p) {
    extern __shared__ __attribute__((aligned(16))) unsigned char lds_raw[];
    LAS unsigned char* lds = (LAS unsigned char*)lds_raw;
    cg::grid_group grid = cg::this_grid();
    const int tid = threadIdx.x, lane = tid & 63, wave = tid >> 6;
    const int G = gridDim.x, gw = blockIdx.x * NWAVES + wave, NGW = G * NWAVES;
    unsigned char* ws = p.ws;

    phase0(p, lds, gw, NGW, wave, lane);
    grid.sync();
    {
        pg8::SchedStd S; S.init(TOK, 4096, G, (int)blockIdx.x); S.A = (const bf16_t*)(ws + WS_XN); S.Bt = (const bf16_t*)(ws + WS_WIN); S.K = DM;
        bf16_t* qb = (bf16_t*)p.out;
        pg8::EpiP1 E{qb, qb + (size_t)TOK * DM, (bf16_t*)(ws + WS_V), (bf16_t*)(ws + WS_UPF), (bf16_t*)(ws + WS_QM)};
        pg8::gemm_phase<pg8::EpiP1, pg8::SchedStd, true>(lds, DM, S, E);
        pg8::SchedStd S2; S2.init(BATCH * MEMTOK, DM, G, (int)blockIdx.x); S2.A = (const bf16_t*)(ws + WS_MEMN); S2.Bt = (const bf16_t*)(ws + WS_WMKV); S2.K = DM;
        pg8::EpiBf16Plain E2{(bf16_t*)(ws + WS_KVM), DM};
        pg8::gemm_phase<pg8::EpiBf16Plain, pg8::SchedStd, true>(lds, DM, S2, E2);
    }
    grid.sync();
    {
        const float lam = lam_value(p);
        const bf16_t* Qb = (const bf16_t*)p.out; const bf16_t* Kb = Qb + (size_t)TOK * DM; const bf16_t* Vb = (const bf16_t*)(ws + WS_V);
        bf16_t* an = (bf16_t*)(ws + WS_AN); f32x4* stash = (f32x4*)(ws + WS_MIX) + (size_t)blockIdx.x * 16 * 512;
        const int vcu = (G % 8 == 0) ? (int)(blockIdx.x % 8) * (G / 8) + (int)blockIdx.x / 8 : (int)blockIdx.x;
        for (int pi = vcu; pi < 256; pi += G) {
            const int bh = pi >> 4, s = pi & 15, b = bh >> 3, h = bh & 7;
            const float slope2 = exp2f(-(float)(h + 1)) * LOG2E;
            for (int it = 0; it < 4; ++it) {
                const int qb = (it >> 1) ? 31 - s : s, c = it & 1; const size_t row0 = (size_t)b * SEQ + (size_t)qb * 256;
                dat::BlockRef r{Qb + row0 * DM + h * 128 + c * 64, Kb + (size_t)b * SEQ * DM + h * 128 + c * 64, Vb + (size_t)b * SEQ * DM + h * 128, qb * 256};
                dat::diff_block(c, r, slope2, lam, stash, an + row0 * DM + h * 128, (char*)lds_raw);
            }
        }
    }
    phase2_mem(p, gw, NGW, lane);
    phase2_pool(p, blockIdx.x * NTHREADS + tid, G * NTHREADS);
    grid.sync();
    {
        pg8::SchedGate S; S.init(TOK, DM, G, (int)blockIdx.x);
        S.xn = (const bf16_t*)(ws + WS_XN); S.wg = (const bf16_t*)(ws + WS_WIN) + (size_t)4096 * DM; S.an = (const bf16_t*)(ws + WS_AN); S.watt = (const bf16_t*)(ws + WS_WATT);
        S.po = (const bf16_t*)(ws + WS_PO); S.wpm = (const bf16_t*)(ws + WS_WPM);
        pg8::EpiGate E{(f32x4*)p.out + (size_t)blockIdx.x * 32 * 512, (f32x4*)(ws + WS_GP) + (size_t)blockIdx.x * 32 * 512, (bf16_t*)(ws + WS_MIX)};
        pg8::gemm_phase<pg8::EpiGate, pg8::SchedGate, true>(lds, DM, S, E);
    }
    grid.sync();
    {
        pg8::SchedStd S; S.init(TOK, DM, G, (int)blockIdx.x); S.A = (const bf16_t*)(ws + WS_MIX); S.Bt = (const bf16_t*)(ws + WS_WOUT); S.K = DM;
        pg8::EpiF32 E{(float*)(ws + WS_Z), DM};
        pg8::gemm_phase<pg8::EpiF32, pg8::SchedStd, false>(lds, DM, S, E);
    }
    grid.sync();
    norm_res_rows((const float*)(ws + WS_Z), p.in[0], p.in[17], p.out, (bf16_t*)(ws + WS_XN2), gw, NGW, lane);
    grid.sync();
    {
        pg8::SchedUp S; S.init2(G, (int)blockIdx.x); S.xn2 = (const bf16_t*)(ws + WS_XN2); S.wup = (const bf16_t*)(ws + WS_WUP);
        pg8::EpiConv E{(bf16_t*)(ws + WS_FF), p.in[20], p.in[21], (LAS f32x4*)(lds + pg8::STAGE_BYTES)};
        pg8::gemm_phase<pg8::EpiConv, pg8::SchedUp, true>(lds, DM, S, E);
    }
    grid.sync();
    {
        pg8::SchedStd S; S.init(TOK, DM, G, (int)blockIdx.x); S.A = (const bf16_t*)(ws + WS_FF); S.Bt = (const bf16_t*)(ws + WS_WDN); S.K = DFF;
        pg8::EpiF32 E{(float*)(ws + WS_Z), DM};
        pg8::gemm_phase<pg8::EpiF32, pg8::SchedStd, false>(lds, DFF, S, E);
    }
    grid.sync();
    norm_res_rows((const float*)(ws + WS_Z), p.out, p.in[23], p.out, nullptr, gw, NGW, lane);
}

extern "C" void kernel_launch(void* const* d_in, const int* in_sizes, int n_in, void* d_out, int out_size, void* d_ws, size_t ws_size, hipStream_t stream) {
    static int grid = 0;
    if (grid == 0) {
        if (n_in != 24 || out_size != TOK * DM || ws_size < WS_END) { fprintf(stderr, "kernel_launch: unexpected shapes (n_in %d out %d ws %zu)\n", n_in, out_size, ws_size); grid = -1; return; }
        int dev = 0, cus = 0, per_cu = 0;
        (void)hipGetDevice(&dev); (void)hipDeviceGetAttribute(&cus, hipDeviceAttributeMultiprocessorCount, dev);
        (void)hipFuncSetAttribute((const void*)mega_fwd, hipFuncAttributeMaxDynamicSharedMemorySize, LDS_BYTES);
        if (hipOccupancyMaxActiveBlocksPerMultiprocessor(&per_cu, (const void*)mega_fwd, NTHREADS, LDS_BYTES) != hipSuccess || per_cu < 1) per_cu = 1;
        grid = cus * per_cu;
        if (grid <= 0) grid = 256;
    }
    if (grid < 0) return;
    Params p{};
    for (int i = 0; i < 24; ++i) p.in[i] = (const float*)d_in[i];
    p.out = (float*)d_out; p.ws = (unsigned char*)d_ws;
    void* args[] = {&p};
    hipError_t e = hipLaunchCooperativeKernel((const void*)mega_fwd, dim3(grid), dim3(NTHREADS), args, LDS_BYTES, stream);
    if (e != hipSuccess) fprintf(stderr, "cooperative launch failed: %s (grid %d)\n", hipGetErrorString(e), grid);
}
```
